# Optimizing an MI355X kernel written in HIP

```python
import math
import jax, jax.numpy as jnp
from jax import lax
import numpy as np

D_MODEL = 1024
BATCH = 2
SEQ = 8192
DEPTH = 2

CHUNK = 64
Q_BLOCK = 128
PLE_DIM = 256
MLA_HEADS = 4
MLA_NOPE = 64
MLA_ROPE = 32
MLA_V = 64
MLA_Q_RANK = 192
MLA_KV_RANK = 128
ROPE_THETA = 10000.0
DIFF_HEADS = 4
DIFF_QK = 64
DIFF_V = 2 * DIFF_QK
SB_HEADS = 4
SB_D = 64
REL_BUCKETS = 32
REL_MAX_DIST = 128
N_EXPERTS = 16
N_GROUPS = 4
EXPERTS_PER_GROUP = N_EXPERTS // N_GROUPS
TOP_K = 2
D_EXPERT = 512
MLA_IN = MLA_Q_RANK + MLA_KV_RANK + MLA_ROPE
DIFF_IN = 2 * DIFF_HEADS * 2 * DIFF_QK + DIFF_HEADS * DIFF_V
SB_IN = 3 * SB_HEADS * SB_D
D_IN = MLA_IN + DIFF_IN + SB_IN
D_MIX = MLA_HEADS * MLA_V + DIFF_HEADS * DIFF_V + SB_HEADS * SB_D
DEEPNORM_ALPHA = (2 * DEPTH) ** 0.25
DEEPNORM_BETA = (8 * DEPTH) ** -0.25
EPS = 1e-5
NEG_INF = -1e30

kernel_name = "hybrid_chunk_causal_mla_diff_stickbreak_moe"


def layer_norm(x, g, b):
    xf = x.astype(jnp.float32)
    mu = jnp.mean(xf, -1, keepdims=True)
    var = jnp.mean(jnp.square(xf - mu), -1, keepdims=True)
    y = (xf - mu) * lax.rsqrt(var + EPS) * g.astype(jnp.float32) + b.astype(jnp.float32)
    return y.astype(x.dtype)


def rms_norm(x, g):
    xf = x.astype(jnp.float32)
    y = xf * lax.rsqrt(jnp.mean(xf * xf, -1, keepdims=True) + EPS) * g.astype(jnp.float32)
    return y.astype(x.dtype)


def rope(x, pos):
    half = x.shape[-1] // 2
    inv = ROPE_THETA ** (-jnp.arange(half, dtype=jnp.float32) / half)
    ang = pos.astype(jnp.float32)[..., None] * inv
    cos, sin = jnp.cos(ang), jnp.sin(ang)
    xf = x.astype(jnp.float32)
    x1, x2 = xf[..., :half], xf[..., half:]
    return jnp.concatenate([x1 * cos - x2 * sin, x1 * sin + x2 * cos], -1).astype(x.dtype)


def t5_bucket(rel):
    nb = REL_BUCKETS // 2
    max_exact = nb // 2
    side = jnp.where(rel > 0, nb, 0)
    n = jnp.abs(rel)
    nf = jnp.maximum(n, 1).astype(jnp.float32)
    large = max_exact + (jnp.log(nf / max_exact) / math.log(REL_MAX_DIST / max_exact)
                         * (nb - max_exact)).astype(jnp.int32)
    large = jnp.minimum(large, nb - 1)
    return side + jnp.where(n < max_exact, n, large)


def to_heads(a, n_heads):
    B, S, _ = a.shape
    return a.reshape(B, S, n_heads, -1).transpose(0, 2, 1, 3)


def merge_heads(a):
    B, H, S, d = a.shape
    return a.transpose(0, 2, 1, 3).reshape(B, S, H * d)


def chunk_mask(n, S):
    q_idx = n * Q_BLOCK + jnp.arange(Q_BLOCK)
    k_idx = jnp.arange(S)
    return (k_idx[None, :] // CHUNK) <= (q_idx[:, None] // CHUNK)


def sweep_query_blocks(block_fn, q_parts):
    B, H, S, _ = q_parts[0].shape
    nb = S // Q_BLOCK

    def to_blocks(a):
        return jnp.moveaxis(a.reshape(B, H, nb, Q_BLOCK, a.shape[-1]), 2, 0)

    out = lax.map(lambda args: block_fn(args[0], *args[1:]),
                  (jnp.arange(nb, dtype=jnp.int32),) + tuple(to_blocks(a) for a in q_parts))
    return jnp.moveaxis(out, 0, 2).reshape(B, H, S, out.shape[-1])


def mla_mixer(u, positions, q_norm, w_uq, kv_norm, w_ukv):
    S = u.shape[1]
    c_q, c_kv, k_r = jnp.split(u, [MLA_Q_RANK, MLA_Q_RANK + MLA_KV_RANK], axis=-1)
    q = to_heads(rms_norm(c_q, q_norm) @ w_uq, MLA_HEADS)
    q_nope = q[..., :MLA_NOPE]
    q_rope = rope(q[..., MLA_NOPE:], positions[:, None, :])
    kv = to_heads(rms_norm(c_kv, kv_norm) @ w_ukv, MLA_HEADS)
    k_nope, v = kv[..., :MLA_NOPE], kv[..., MLA_NOPE:]
    k_rope = rope(k_r, positions)
    scale = (MLA_NOPE + MLA_ROPE) ** -0.5

    def block(n, qn, qr):
        s = (jnp.einsum('bhqd,bhkd->bhqk', qn, k_nope)
             + jnp.einsum('bhqd,bkd->bhqk', qr, k_rope)).astype(jnp.float32) * scale
        a = jax.nn.softmax(jnp.where(chunk_mask(n, S), s, NEG_INF), axis=-1)
        return jnp.einsum('bhqk,bhkd->bhqd', a.astype(v.dtype), v)

    return merge_heads(sweep_query_blocks(block, (q_nope, q_rope)))


def diff_mixer(u, positions, rel_bias, lq1, lk1, lq2, lk2, subln, lam_init):
    B, S, _ = u.shape
    qk_w = DIFF_HEADS * 2 * DIFF_QK
    q, k, v = jnp.split(u, [qk_w, 2 * qk_w], axis=-1)
    q = q.reshape(B, S, DIFF_HEADS, 2, DIFF_QK).transpose(3, 0, 2, 1, 4)
    k = k.reshape(B, S, DIFF_HEADS, 2, DIFF_QK).transpose(3, 0, 2, 1, 4)
    v = to_heads(v, DIFF_HEADS)
    f = lambda a: a.astype(jnp.float32)
    lam = jnp.exp(jnp.sum(f(lq1) * f(lk1))) - jnp.exp(jnp.sum(f(lq2) * f(lk2))) + lam_init
    scale = DIFF_QK ** -0.5

    def block(n, q1, q2):
        mask = chunk_mask(n, S)
        pos_blk = lax.dynamic_slice_in_dim(positions, n * Q_BLOCK, Q_BLOCK, axis=1)
        rel = positions[:, None, :] - pos_blk[:, :, None]
        bias = jnp.moveaxis(rel_bias[t5_bucket(rel)], -1, 1).astype(jnp.float32)

        def attn_map(qq, kk):
            s = jnp.einsum('bhqd,bhkd->bhqk', qq, kk).astype(jnp.float32) * scale + bias
            return jax.nn.softmax(jnp.where(mask, s, NEG_INF), axis=-1)

        a = attn_map(q1, k[0]) - lam * attn_map(q2, k[1])
        return jnp.einsum('bhqk,bhkd->bhqd', a.astype(v.dtype), v)

    o = sweep_query_blocks(block, (q[0], q[1]))
    o = rms_norm(o, subln) * (1.0 - lam_init)
    return merge_heads(o)


def sb_mixer(u):
    S = u.shape[1]
    q, k, v = [to_heads(a, SB_HEADS) for a in jnp.split(u, 3, axis=-1)]
    scale = SB_D ** -0.5

    def block(n, qb):
        q_idx = n * Q_BLOCK + jnp.arange(Q_BLOCK)
        strict = jnp.arange(S)[None, :] < q_idx[:, None]
        z = jnp.einsum('bhqd,bhkd->bhqk', qb, k).astype(jnp.float32) * scale
        log_fail = jnp.where(strict, jax.nn.log_sigmoid(-z), 0.0)
        later = lax.cumsum(log_fail, axis=3, reverse=True) - log_fail
        w = jnp.where(strict, jnp.exp(jax.nn.log_sigmoid(z) + later), 0.0)
        return jnp.einsum('bhqk,bhkd->bhqd', w.astype(v.dtype), v)

    return merge_heads(sweep_query_blocks(block, (q,)))


def grouped_moe(h, router_w, router_b, w_gate, w_up, w_down):
    scores = jax.nn.sigmoid((h @ router_w).astype(jnp.float32))
    sel = scores + router_b.astype(jnp.float32)
    g = sel.reshape(sel.shape[:-1] + (N_GROUPS, EXPERTS_PER_GROUP))
    group_score = jnp.sum(lax.top_k(g, 2)[0], axis=-1)
    best_group = jnp.argmax(group_score, axis=-1)
    in_group = jnp.arange(N_GROUPS) == best_group[..., None]
    masked = jnp.where(in_group[..., None], g, -jnp.inf).reshape(sel.shape)
    _, idx = lax.top_k(masked, TOP_K)
    wts = jnp.take_along_axis(scores, idx, axis=-1)
    wts = wts / jnp.sum(wts, -1, keepdims=True)
    gate = jnp.sum(jax.nn.one_hot(idx, N_EXPERTS, dtype=jnp.float32) * wts[..., None], axis=-2)
    gate = gate.astype(h.dtype)
    out = jnp.zeros_like(h)
    for e in range(N_EXPERTS):
        hid = jax.nn.silu(h @ w_gate[e]) * (h @ w_up[e])
        out = out + gate[..., e:e + 1] * (hid @ w_down[e])
    return out


def setup_inputs(seed: int = 0) -> dict:
    key = jax.random.key(seed)
    ks = jax.random.split(key, 32)
    f32 = jnp.float32

    def nrm(k, shape, scale):
        return jax.random.normal(k, shape, f32) * scale

    x = nrm(ks[0], (BATCH, SEQ, D_MODEL), 1.0)
    p = nrm(ks[1], (DEPTH, BATCH, SEQ, PLE_DIM), 1.0)
    offset = jax.random.randint(ks[2], (BATCH, 1), 0, 64, dtype=jnp.int32) * CHUNK
    positions = (jnp.arange(SEQ, dtype=jnp.int32)[None, :] + offset).astype(jnp.int32)
    return {
        'x': x,
        'p': p,
        'positions': positions,
        'w_in': nrm(ks[3], (DEPTH, D_MODEL, D_IN), D_MODEL ** -0.5),
        'mla_q_norm': 1.0 + nrm(ks[4], (DEPTH, MLA_Q_RANK), 0.05),
        'mla_w_uq': nrm(ks[5], (DEPTH, MLA_Q_RANK, MLA_HEADS * (MLA_NOPE + MLA_ROPE)), MLA_Q_RANK ** -0.5),
        'mla_kv_norm': 1.0 + nrm(ks[6], (DEPTH, MLA_KV_RANK), 0.05),
        'mla_w_ukv': nrm(ks[7], (DEPTH, MLA_KV_RANK, MLA_HEADS * (MLA_NOPE + MLA_V)), MLA_KV_RANK ** -0.5),
        'diff_lambda_q1': nrm(ks[8], (DEPTH, DIFF_QK), 0.1),
        'diff_lambda_k1': nrm(ks[9], (DEPTH, DIFF_QK), 0.1),
        'diff_lambda_q2': nrm(ks[10], (DEPTH, DIFF_QK), 0.1),
        'diff_lambda_k2': nrm(ks[11], (DEPTH, DIFF_QK), 0.1),
        'diff_subln': 1.0 + nrm(ks[12], (DEPTH, DIFF_V), 0.05),
        'rel_bias': nrm(ks[13], (REL_BUCKETS, DIFF_HEADS), 0.5),
        'w_o': nrm(ks[14], (DEPTH, D_MIX, D_MODEL), D_MIX ** -0.5 * DEEPNORM_BETA),
        'ln1_g': 1.0 + nrm(ks[15], (DEPTH, D_MODEL), 0.05),
        'ln1_b': nrm(ks[16], (DEPTH, D_MODEL), 0.02),
        'router_w': nrm(ks[17], (D_MODEL, N_EXPERTS), D_MODEL ** -0.5),
        'router_b': nrm(ks[18], (N_EXPERTS,), 0.01),
        'w_gate': nrm(ks[19], (DEPTH, N_EXPERTS, D_MODEL, D_EXPERT), D_MODEL ** -0.5),
        'w_up': nrm(ks[20], (DEPTH, N_EXPERTS, D_MODEL, D_EXPERT), D_MODEL ** -0.5),
        'w_down': nrm(ks[21], (DEPTH, N_EXPERTS, D_EXPERT, D_MODEL), D_EXPERT ** -0.5 * DEEPNORM_BETA),
        'ple_proj': nrm(ks[22], (DEPTH, PLE_DIM, D_MODEL), PLE_DIM ** -0.5 * DEEPNORM_BETA),
        'ple_gate': nrm(ks[23], (DEPTH, D_MODEL, D_MODEL), D_MODEL ** -0.5),
        'ln2_g': 1.0 + nrm(ks[24], (DEPTH, D_MODEL), 0.05),
        'ln2_b': nrm(ks[25], (DEPTH, D_MODEL), 0.02),
    }


def reference(x, p, positions, w_in, mla_q_norm, mla_w_uq, mla_kv_norm, mla_w_ukv,
              diff_lambda_q1, diff_lambda_k1, diff_lambda_q2, diff_lambda_k2, diff_subln,
              rel_bias, w_o, ln1_g, ln1_b, router_w, router_b, w_gate, w_up, w_down,
              ple_proj, ple_gate, ln2_g, ln2_b):
    h = x
    for i in range(DEPTH):
        u = h @ w_in[i]
        u_mla, u_diff, u_sb = jnp.split(u, [MLA_IN, MLA_IN + DIFF_IN], axis=-1)
        y_mla = mla_mixer(u_mla, positions, mla_q_norm[i], mla_w_uq[i], mla_kv_norm[i], mla_w_ukv[i])
        lam_init = 0.8 - 0.6 * math.exp(-0.3 * i)
        y_diff = diff_mixer(u_diff, positions, rel_bias, diff_lambda_q1[i], diff_lambda_k1[i],
                            diff_lambda_q2[i], diff_lambda_k2[i], diff_subln[i], lam_init)
        y_sb = sb_mixer(u_sb)
        mix = jnp.concatenate([y_mla, y_diff, y_sb], axis=-1) @ w_o[i]
        h = layer_norm(DEEPNORM_ALPHA * h + mix, ln1_g[i], ln1_b[i])
        ffn = grouped_moe(h, router_w, router_b, w_gate[i], w_up[i], w_down[i])
        ple = jax.nn.sigmoid(h @ ple_gate[i]) * (p[i] @ ple_proj[i])
        h = layer_norm(DEEPNORM_ALPHA * h + ffn + ple, ln2_g[i], ln2_b[i])
    return h
```

```cpp
#include <hip/hip_runtime.h>
#include <cmath>
namespace nv {
constexpr int B_ = 2, S_ = 8192, M_ = B_ * S_, D_ = 1024, DIN_ = 2656;
constexpr float EPS_ = 1e-5f;
constexpr float ALPHA_ = 1.41421356237309515f;

template <class Epi>
__global__ void __launch_bounds__(256) gemm(const float* __restrict__ A, const int* __restrict__ gather, const int* __restrict__ cntp, const float* __restrict__ Bm, Epi epi,
                                            int lda, int Mmax, int ldb, int K) {
    const int Mc = cntp ? *cntp : Mmax;
    const int m0 = blockIdx.y * 64, n0 = blockIdx.x * 32;
    if (m0 >= Mc) return;
    __shared__ float As[16][65];
    __shared__ float Bs[16][33];
    const int tid = threadIdx.x, tx = tid & 7, ty = tid >> 3;
    float acc[2][4];
#pragma unroll
    for (int i = 0; i < 2; ++i)
#pragma unroll
        for (int j = 0; j < 4; ++j) acc[i][j] = 0.f;
    const int ar = tid >> 2, ak = (tid & 3) * 4;
    const int am = m0 + ar; const bool aval = am < Mc; const int arow = aval ? (gather ? gather[am] : am) : 0;
    const float* Ap = A + (size_t)arow * lda + ak;
    const int bk = tid >> 4, bn = (tid & 15) * 2;
    const float* Bp = Bm + (size_t)bk * ldb + n0 + bn;
    for (int k0 = 0; k0 < K; k0 += 16) {
        float4 av = aval ? *(const float4*)(Ap + k0) : make_float4(0.f, 0.f, 0.f, 0.f);
        float2 bv = *(const float2*)(Bp + (size_t)k0 * ldb);
        As[ak + 0][ar] = av.x; As[ak + 1][ar] = av.y; As[ak + 2][ar] = av.z; As[ak + 3][ar] = av.w;
        Bs[bk][bn] = bv.x; Bs[bk][bn + 1] = bv.y;
        __syncthreads();
#pragma unroll
        for (int kk = 0; kk < 16; ++kk) {
            float a0 = As[kk][ty * 2], a1 = As[kk][ty * 2 + 1];
#pragma unroll
            for (int j = 0; j < 4; ++j) { float b = Bs[kk][tx * 4 + j]; acc[0][j] += a0 * b; acc[1][j] += a1 * b; }
        }
        __syncthreads();
    }
#pragma unroll
    for (int i = 0; i < 2; ++i) { const int m = m0 + ty * 2 + i; if (m < Mc) {
#pragma unroll
        for (int j = 0; j < 4; ++j) epi(m, n0 + tx * 4 + j, acc[i][j]); } }
}
struct EpiStore { float* C; int ldc; int pad; __device__ void operator()(int m, int n, float v) const { C[(size_t)m * ldc + n] = v; } };
struct EpiResid { float* C; const float* H; __device__ void operator()(int m, int n, float v) const { C[(size_t)m * D_ + n] = ALPHA_ * H[(size_t)m * D_ + n] + v; } };
struct EpiPle { float* C; const float* H1; __device__ void operator()(int m, int n, float v) const {
    const size_t o = (size_t)m * D_ + n; C[o] = ALPHA_ * H1[o] + C[o] / (1.f + expf(-v)); } };
struct EpiRowMap { float* C; const int* rowmap; int ldc; int pad; __device__ void operator()(int m, int n, float v) const { C[(size_t)rowmap[m] * ldc + n] = v; } };
struct EpiSiluMul { float* HID; const int* rowmap; __device__ void operator()(int m, int n, float v) const {
    const size_t o = (size_t)rowmap[m] * 512 + n; const float g = HID[o]; HID[o] = g / (1.f + expf(-g)) * v; } };
struct EpiDown { float* T2; const int* tok; const float* w; __device__ void operator()(int m, int n, float v) const { T2[(size_t)tok[m] * D_ + n] += w[m] * v; } };

__device__ __forceinline__ float block_sum256(float v, float* red) {
#pragma unroll
    for (int o = 32; o > 0; o >>= 1) v += __shfl_xor(v, o);
    __syncthreads();
    if ((threadIdx.x & 63) == 0) red[threadIdx.x >> 6] = v;
    __syncthreads();
    return red[0] + red[1] + red[2] + red[3];
}
__global__ void __launch_bounds__(256) ln(const float* __restrict__ T, const float* __restrict__ A2, const float* __restrict__ A3, const float* __restrict__ g, const float* __restrict__ b, float* __restrict__ out) {
    __shared__ float red[4];
    const int m = blockIdx.x, t = threadIdx.x;
    float x[4]; float s = 0.f;
#pragma unroll
    for (int j = 0; j < 4; ++j) { const int c = t + 256 * j; float v = T[(size_t)m * D_ + c]; if (A2) v += A2[(size_t)m * D_ + c]; if (A3) v += A3[(size_t)m * D_ + c]; x[j] = v; s += v; }
    const float mu = block_sum256(s, red) * (1.f / D_);
    float q = 0.f;
#pragma unroll
    for (int j = 0; j < 4; ++j) { const float d = x[j] - mu; q += d * d; }
    const float var = block_sum256(q, red) * (1.f / D_);
    const float rs = rsqrtf(var + EPS_);
#pragma unroll
    for (int j = 0; j < 4; ++j) { const int c = t + 256 * j; out[(size_t)m * D_ + c] = (x[j] - mu) * rs * g[c] + b[c]; }
}
__global__ void __launch_bounds__(64) mla_prep(const float* __restrict__ U, const int* __restrict__ pos, const float* __restrict__ gq, const float* __restrict__ gkv,
                                               float* __restrict__ CQN, float* __restrict__ CKVN, float* __restrict__ KR) {
    const int m = blockIdx.x, l = threadIdx.x; const float* u = U + (size_t)m * DIN_;
    float a0 = u[l], a1 = u[64 + l], a2 = u[128 + l];
    float s = a0 * a0 + a1 * a1 + a2 * a2;
#pragma unroll
    for (int o = 32; o > 0; o >>= 1) s += __shfl_xor(s, o);
    const float rq = rsqrtf(s * (1.f / 192.f) + EPS_);
    CQN[(size_t)m * 192 + l] = a0 * rq * gq[l]; CQN[(size_t)m * 192 + 64 + l] = a1 * rq * gq[64 + l]; CQN[(size_t)m * 192 + 128 + l] = a2 * rq * gq[128 + l];
    float b0 = u[192 + l], b1 = u[256 + l];
    float s2 = b0 * b0 + b1 * b1;
#pragma unroll
    for (int o = 32; o > 0; o >>= 1) s2 += __shfl_xor(s2, o);
    const float rk = rsqrtf(s2 * (1.f / 128.f) + EPS_);
    CKVN[(size_t)m * 128 + l] = b0 * rk * gkv[l]; CKVN[(size_t)m * 128 + 64 + l] = b1 * rk * gkv[64 + l];
    if (l < 16) {
        const float inv = powf(10000.f, -(float)l / 16.f); const float ang = (float)pos[m] * inv; const float c = cosf(ang), sn = sinf(ang);
        const float x1 = u[320 + l], x2 = u[336 + l];
        KR[(size_t)m * 32 + l] = x1 * c - x2 * sn; KR[(size_t)m * 32 + 16 + l] = x1 * sn + x2 * c;
    }
}
__global__ void __launch_bounds__(64) mla_qrope(float* __restrict__ Q, const int* __restrict__ pos) {
    const int m = blockIdx.x, l = threadIdx.x, h = l >> 4, i = l & 15;
    const float inv = powf(10000.f, -(float)i / 16.f); const float ang = (float)pos[m] * inv; const float c = cosf(ang), sn = sinf(ang);
    float* q = Q + (size_t)m * 384 + h * 96 + 64;
    const float x1 = q[i], x2 = q[16 + i];
    q[i] = x1 * c - x2 * sn; q[16 + i] = x1 * sn + x2 * c;
}
__global__ void __launch_bounds__(64) attn_mla(const float* __restrict__ Q, const float* __restrict__ KV, const float* __restrict__ KR, float* __restrict__ MIX) {
    const int c = blockIdx.x & 127, h = (blockIdx.x >> 7) & 3, b = blockIdx.x >> 9, lane = threadIdx.x;
    const int m = b * S_ + c * 64 + lane;
    float qv[96], o[64];
#pragma unroll
    for (int d = 0; d < 96; ++d) qv[d] = Q[(size_t)m * 384 + h * 96 + d];
#pragma unroll
    for (int d = 0; d < 64; ++d) o[d] = 0.f;
    float mx = -1e30f, l = 0.f; const float scale = 0.10206207261596577f;
    const int nk = (c + 1) * 64;
    for (int j = 0; j < nk; ++j) {
        const float* kn = KV + (size_t)(b * S_ + j) * 512 + h * 128; const float* kr = KR + (size_t)(b * S_ + j) * 32;
        float s = 0.f;
#pragma unroll
        for (int d = 0; d < 64; ++d) s += qv[d] * kn[d];
#pragma unroll
        for (int d = 0; d < 32; ++d) s += qv[64 + d] * kr[d];
        s *= scale;
        const float mn = fmaxf(mx, s), a = expf(mx - mn), p = expf(s - mn);
        l = l * a + p; mx = mn;
#pragma unroll
        for (int d = 0; d < 64; ++d) o[d] = o[d] * a + p * kn[64 + d];
    }
    const float il = 1.f / l;
#pragma unroll
    for (int d = 0; d < 64; ++d) MIX[(size_t)m * D_ + h * 64 + d] = o[d] * il;
}
__device__ __forceinline__ int t5_bucket(int rel) {
    const int side = rel > 0 ? 16 : 0; const int n = rel < 0 ? -rel : rel;
    int v;
    if (n < 8) v = n; else if (n < 12) v = 8; else if (n < 16) v = 9; else if (n < 23) v = 10; else if (n < 32) v = 11; else if (n < 46) v = 12; else if (n < 64) v = 13; else if (n < 91) v = 14; else v = 15;
    return side + v;
}
__global__ void __launch_bounds__(64) attn_diff(const float* __restrict__ U, const int* __restrict__ pos, const float* __restrict__ rel_bias,
                                                const float* __restrict__ lq1, const float* __restrict__ lk1, const float* __restrict__ lq2, const float* __restrict__ lk2, float* __restrict__ MIX, float lam_init) {
    const int c = blockIdx.x & 127, vh = (blockIdx.x >> 7) & 1, h = (blockIdx.x >> 8) & 3, b = blockIdx.x >> 10, lane = threadIdx.x;
    const int m = b * S_ + c * 64 + lane;
    float q1[64], q2[64], o1[64], o2[64];
#pragma unroll
    for (int d = 0; d < 64; ++d) { q1[d] = U[(size_t)m * DIN_ + 352 + h * 128 + d]; q2[d] = U[(size_t)m * DIN_ + 352 + h * 128 + 64 + d]; o1[d] = 0.f; o2[d] = 0.f; }
    float mx1 = -1e30f, l1 = 0.f, mx2 = -1e30f, l2 = 0.f; const int pq = pos[m];
    const int nk = (c + 1) * 64;
    for (int j = 0; j < nk; ++j) {
        const float* ur = U + (size_t)(b * S_ + j) * DIN_ + 352;
        const float* k1 = ur + 512 + h * 128; const float* k2 = k1 + 64; const float* vv = ur + 1024 + h * 128 + vh * 64;
        float s1 = 0.f, s2 = 0.f;
#pragma unroll
        for (int d = 0; d < 64; ++d) { s1 += q1[d] * k1[d]; s2 += q2[d] * k2[d]; }
        const float bias = rel_bias[t5_bucket(pos[b * S_ + j] - pq) * 4 + h];
        s1 = s1 * 0.125f + bias; s2 = s2 * 0.125f + bias;
        const float mn1 = fmaxf(mx1, s1), a1 = expf(mx1 - mn1), p1 = expf(s1 - mn1); l1 = l1 * a1 + p1; mx1 = mn1;
        const float mn2 = fmaxf(mx2, s2), a2 = expf(mx2 - mn2), p2 = expf(s2 - mn2); l2 = l2 * a2 + p2; mx2 = mn2;
#pragma unroll
        for (int d = 0; d < 64; ++d) { const float v = vv[d]; o1[d] = o1[d] * a1 + p1 * v; o2[d] = o2[d] * a2 + p2 * v; }
    }
    float t1 = 0.f, t2 = 0.f;
    for (int i = 0; i < 64; ++i) { t1 += lq1[i] * lk1[i]; t2 += lq2[i] * lk2[i]; }
    const float lam = expf(t1) - expf(t2) + lam_init;
    const float il1 = 1.f / l1, il2 = lam / l2;
#pragma unroll
    for (int d = 0; d < 64; ++d) MIX[(size_t)m * D_ + 256 + h * 128 + vh * 64 + d] = o1[d] * il1 - o2[d] * il2;
}
__global__ void __launch_bounds__(128) diff_norm(const float* __restrict__ subln, float* __restrict__ MIX, float lam_init) {
    __shared__ float red[2];
    const int m = blockIdx.x >> 2, h = blockIdx.x & 3, d = threadIdx.x;
    const float o = MIX[(size_t)m * D_ + 256 + h * 128 + d];
    float q = o * o;
#pragma unroll
    for (int k = 32; k > 0; k >>= 1) q += __shfl_xor(q, k);
    if ((d & 63) == 0) red[d >> 6] = q;
    __syncthreads();
    const float r = rsqrtf((red[0] + red[1]) * (1.f / 128.f) + EPS_);
    MIX[(size_t)m * D_ + 256 + h * 128 + d] = o * r * subln[d] * (1.f - lam_init);
}
__global__ void __launch_bounds__(64) attn_sb(const float* __restrict__ U, float* __restrict__ MIX) {
    const int c = blockIdx.x & 127, h = (blockIdx.x >> 7) & 3, b = blockIdx.x >> 9, lane = threadIdx.x;
    const int qi = c * 64 + lane, m = b * S_ + qi;
    float qv[64], o[64];
#pragma unroll
    for (int d = 0; d < 64; ++d) { qv[d] = U[(size_t)m * DIN_ + 1888 + h * 64 + d]; o[d] = 0.f; }
    float carry = 0.f;
    for (int j = c * 64 + 63; j >= 0; --j) {
        const float* ur = U + (size_t)(b * S_ + j) * DIN_ + 1888; const float* kk = ur + 256 + h * 64; const float* vv = ur + 512 + h * 64;
        float z = 0.f;
#pragma unroll
        for (int d = 0; d < 64; ++d) z += qv[d] * kk[d];
        z *= 0.125f;
        const float t = log1pf(expf(-fabsf(z)));
        const float ls = fminf(z, 0.f) - t, lf = fminf(-z, 0.f) - t;
        const bool valid = j < qi;
        const float w = valid ? expf(ls + carry) : 0.f;
        if (valid) carry += lf;
#pragma unroll
        for (int d = 0; d < 64; ++d) o[d] += w * vv[d];
    }
#pragma unroll
    for (int d = 0; d < 64; ++d) MIX[(size_t)m * D_ + 768 + h * 64 + d] = o[d];
}
__global__ void __launch_bounds__(64) router(const float* __restrict__ H1, const float* __restrict__ rw, const float* __restrict__ rb, int* __restrict__ cnt, int* __restrict__ ltok, int* __restrict__ lslot, float* __restrict__ lw) {
    const int m = blockIdx.x, l = threadIdx.x;
    float acc[16];
#pragma unroll
    for (int e = 0; e < 16; ++e) acc[e] = 0.f;
    for (int k = l; k < D_; k += 64) { const float hv = H1[(size_t)m * D_ + k];
#pragma unroll
        for (int e = 0; e < 16; ++e) acc[e] += hv * rw[k * 16 + e]; }
#pragma unroll
    for (int e = 0; e < 16; ++e) {
#pragma unroll
        for (int o = 32; o > 0; o >>= 1) acc[e] += __shfl_xor(acc[e], o); }
    if (l == 0) {
        float sc[16], sel[16];
#pragma unroll
        for (int e = 0; e < 16; ++e) { sc[e] = 1.f / (1.f + expf(-acc[e])); sel[e] = sc[e] + rb[e]; }
        int bg = 0; float bgs = -1e30f;
#pragma unroll
        for (int g = 0; g < 4; ++g) { float t1 = -1e30f, t2 = -1e30f;
#pragma unroll
            for (int j = 0; j < 4; ++j) { const float v = sel[g * 4 + j]; if (v > t1) { t2 = t1; t1 = v; } else if (v > t2) t2 = v; }
            const float gs = t1 + t2; if (gs > bgs) { bgs = gs; bg = g; } }
        int i1 = 0, i2 = 0; float v1 = -1e30f, v2 = -1e30f, s1 = 0.f, s2 = 0.f;
#pragma unroll
        for (int g = 0; g < 4; ++g)
#pragma unroll
            for (int j = 0; j < 4; ++j) { if (g == bg) { const float v = sel[g * 4 + j]; const int e = g * 4 + j;
                if (v > v1) { v2 = v1; i2 = i1; s2 = s1; v1 = v; i1 = e; s1 = sc[e]; } else if (v > v2) { v2 = v; i2 = e; s2 = sc[e]; } } }
        const float ws = s1 + s2;
        int p1 = atomicAdd(&cnt[i1], 1); ltok[i1 * M_ + p1] = m; lslot[i1 * M_ + p1] = 2 * m; lw[i1 * M_ + p1] = s1 / ws;
        int p2 = atomicAdd(&cnt[i2], 1); ltok[i2 * M_ + p2] = m; lslot[i2 * M_ + p2] = 2 * m + 1; lw[i2 * M_ + p2] = s2 / ws;
    }
}
constexpr size_t MB = 1u << 20;
constexpr size_t W_CTL = 0, W_LIST = 1 * MB;
constexpr size_t W_U = 4 * MB;
constexpr size_t W_R2 = 170 * MB;
constexpr size_t W_MIX = 250 * MB;
constexpr size_t W_END = 314 * MB;

static void forward(void* const* d_in, float* d_out, unsigned char* ws, hipStream_t st) {
    const float* x = (const float*)d_in[0]; const float* p = (const float*)d_in[1]; const int* pos = (const int*)d_in[2];
    const float* w_in = (const float*)d_in[3]; const float* qn = (const float*)d_in[4]; const float* w_uq = (const float*)d_in[5];
    const float* kvn = (const float*)d_in[6]; const float* w_ukv = (const float*)d_in[7];
    const float* lq1 = (const float*)d_in[8]; const float* lk1 = (const float*)d_in[9]; const float* lq2 = (const float*)d_in[10]; const float* lk2 = (const float*)d_in[11];
    const float* subln = (const float*)d_in[12]; const float* rel_bias = (const float*)d_in[13]; const float* w_o = (const float*)d_in[14];
    const float* ln1g = (const float*)d_in[15]; const float* ln1b = (const float*)d_in[16]; const float* rw = (const float*)d_in[17]; const float* rb = (const float*)d_in[18];
    const float* wg = (const float*)d_in[19]; const float* wu = (const float*)d_in[20]; const float* wd = (const float*)d_in[21];
    const float* pproj = (const float*)d_in[22]; const float* pgate = (const float*)d_in[23]; const float* ln2g = (const float*)d_in[24]; const float* ln2b = (const float*)d_in[25];
    int* cnt = (int*)(ws + W_CTL); int* ltok = (int*)(ws + W_LIST); int* lslot = (int*)(ws + W_LIST + 1 * MB); float* lw = (float*)(ws + W_LIST + 2 * MB);
    float* U = (float*)(ws + W_U);
    float* CQN = (float*)(ws + W_R2); float* CKVN = (float*)(ws + W_R2 + 12 * MB); float* KR = (float*)(ws + W_R2 + 20 * MB); float* Q = (float*)(ws + W_R2 + 22 * MB); float* KV = (float*)(ws + W_R2 + 46 * MB);
    float* MIX = (float*)(ws + W_MIX); float* H1 = (float*)(ws + W_R2);
    float* T = U; float* HID = U; float* T2 = (float*)(ws + W_U + 64 * MB);
    for (int i = 0; i < 2; ++i) {
        const float* h = i == 0 ? x : d_out; float* hout = d_out;
        const float lam_init = (float)(0.8 - 0.6 * exp(-0.3 * i));
        hipLaunchKernelGGL(gemm<EpiStore>, dim3(DIN_ / 32, M_ / 64), dim3(256), 0, st, h, nullptr, nullptr, w_in + (size_t)i * D_ * DIN_, EpiStore{U, DIN_, 0}, D_, M_, DIN_, D_);
        hipLaunchKernelGGL(mla_prep, dim3(M_), dim3(64), 0, st, U, pos, qn + i * 192, kvn + i * 128, CQN, CKVN, KR);
        hipLaunchKernelGGL(gemm<EpiStore>, dim3(384 / 32, M_ / 64), dim3(256), 0, st, CQN, nullptr, nullptr, w_uq + (size_t)i * 192 * 384, EpiStore{Q, 384, 0}, 192, M_, 384, 192);
        hipLaunchKernelGGL(gemm<EpiStore>, dim3(512 / 32, M_ / 64), dim3(256), 0, st, CKVN, nullptr, nullptr, w_ukv + (size_t)i * 128 * 512, EpiStore{KV, 512, 0}, 128, M_, 512, 128);
        hipLaunchKernelGGL(mla_qrope, dim3(M_), dim3(64), 0, st, Q, pos);
        hipLaunchKernelGGL(attn_mla, dim3(B_ * 4 * 128), dim3(64), 0, st, Q, KV, KR, MIX);
        hipLaunchKernelGGL(attn_diff, dim3(B_ * 4 * 2 * 128), dim3(64), 0, st, U, pos, rel_bias, lq1 + i * 64, lk1 + i * 64, lq2 + i * 64, lk2 + i * 64, MIX, lam_init);
        hipLaunchKernelGGL(diff_norm, dim3(M_ * 4), dim3(128), 0, st, subln + i * 128, MIX, lam_init);
        hipLaunchKernelGGL(attn_sb, dim3(B_ * 4 * 128), dim3(64), 0, st, U, MIX);
        hipLaunchKernelGGL(gemm<EpiResid>, dim3(D_ / 32, M_ / 64), dim3(256), 0, st, MIX, nullptr, nullptr, w_o + (size_t)i * D_ * D_, EpiResid{T, h}, D_, M_, D_, D_);
        hipLaunchKernelGGL(ln, dim3(M_), dim3(256), 0, st, T, nullptr, nullptr, ln1g + i * D_, ln1b + i * D_, H1);
        (void)hipMemsetAsync(cnt, 0, 64, st);
        hipLaunchKernelGGL(router, dim3(M_), dim3(64), 0, st, H1, rw, rb, cnt, ltok, lslot, lw);
        hipLaunchKernelGGL(gemm<EpiStore>, dim3(D_ / 32, M_ / 64), dim3(256), 0, st, p + (size_t)i * M_ * 256, nullptr, nullptr, pproj + (size_t)i * 256 * D_, EpiStore{T2, D_, 0}, 256, M_, D_, 256);
        hipLaunchKernelGGL(gemm<EpiPle>, dim3(D_ / 32, M_ / 64), dim3(256), 0, st, H1, nullptr, nullptr, pgate + (size_t)i * D_ * D_, EpiPle{T2, H1}, D_, M_, D_, D_);
        for (int e = 0; e < 16; ++e) {
            const float* wge = wg + ((size_t)i * 16 + e) * D_ * 512; const float* wue = wu + ((size_t)i * 16 + e) * D_ * 512;
            hipLaunchKernelGGL(gemm<EpiRowMap>, dim3(512 / 32, M_ / 64), dim3(256), 0, st, H1, ltok + e * M_, cnt + e, wge, EpiRowMap{HID, lslot + e * M_, 512, 0}, D_, M_, 512, D_);
            hipLaunchKernelGGL(gemm<EpiSiluMul>, dim3(512 / 32, M_ / 64), dim3(256), 0, st, H1, ltok + e * M_, cnt + e, wue, EpiSiluMul{HID, lslot + e * M_}, D_, M_, 512, D_);
        }
        for (int e = 0; e < 16; ++e) {
            const float* wde = wd + ((size_t)i * 16 + e) * 512 * D_;
            hipLaunchKernelGGL(gemm<EpiDown>, dim3(D_ / 32, M_ / 64), dim3(256), 0, st, HID, lslot + e * M_, cnt + e, wde, EpiDown{T2, ltok + e * M_, lw + e * M_}, 512, M_, D_, 512);
        }
        hipLaunchKernelGGL(ln, dim3(M_), dim3(256), 0, st, T2, nullptr, nullptr, ln2g + i * D_, ln2b + i * D_, hout);
    }
}
}

extern "C" void kernel_launch(void* const* d_in, const int* in_sizes, int n_in, void* d_out, int out_size, void* d_ws, size_t ws_size, hipStream_t stream) {
    if (ws_size < nv::W_END) return;
    nv::forward(d_in, (float*)d_out, (unsigned char*)d_ws, stream);
}
```

```cpp
#include <hip/hip_runtime.h>
#include <cstdio>
#include <cstdint>
#include <cmath>
#define GAS __attribute__((address_space(1)))
#define LAS __attribute__((address_space(3)))
typedef unsigned short bf16_t;
typedef short bf16x8 __attribute__((ext_vector_type(8)));
typedef short s16x4 __attribute__((ext_vector_type(4)));
typedef float f32x2 __attribute__((ext_vector_type(2)));
typedef float f32x4 __attribute__((ext_vector_type(4)));
typedef float f32x16 __attribute__((ext_vector_type(16)));
typedef unsigned u32x2 __attribute__((ext_vector_type(2)));
typedef unsigned u32x4 __attribute__((ext_vector_type(4)));
typedef GAS unsigned gu32;
#define RLX_AGENT __ATOMIC_RELAXED, __HIP_MEMORY_SCOPE_AGENT

namespace fk {
constexpr int BATCH = 2, SEQ = 8192, M = BATCH * SEQ, D = 1024;
constexpr int UP = 2816;
constexpr int U_CQ = 0, U_CKV = 256, U_KR = 384, U_DQ = 512, U_DK = 1024, U_DV = 1536, U_SQ = 2048, U_SK = 2304, U_SV = 2560;
constexpr float LOG2E = 1.4426950408889634f;
constexpr float QS_DIFF = 0.125f * LOG2E, QS_SB = 0.125f * LOG2E, QS_MLA = 0.10206207261596577f * LOG2E;
constexpr float ALPHA = 1.41421356237309515f, EPS = 1e-5f;

__device__ __forceinline__ unsigned cvt_pk_bf16(float lo, float hi) { unsigned r; asm volatile("v_cvt_pk_bf16_f32 %0, %1, %2" : "=v"(r) : "v"(lo), "v"(hi)); return r; }
__device__ __forceinline__ float bf2f(unsigned short b) { return __uint_as_float((unsigned)b << 16); }
__device__ __forceinline__ float bflo(unsigned w) { return __uint_as_float(w << 16); }
__device__ __forceinline__ float bfhi(unsigned w) { return __uint_as_float(w & 0xffff0000u); }
__device__ __forceinline__ float wave_sum(float v) {
#pragma unroll
    for (int o = 1; o < 64; o <<= 1) v += __shfl_xor(v, o);
    return v;
}
}

namespace pg8 {
constexpr int BM = 256, BK = 64, HALF = 128, HTB = HALF * BK * 2, STAGE_BYTES = 8 * HTB, NXCD = 8, WGM = 8;
__host__ __device__ __forceinline__ int lds_byte(int r, int c) { const int st = (r >> 4) * 2 + (c >> 5), rr = r & 15, cc = c & 31, ob = rr * 64 + cc * 2; return st * 1024 + (ob ^ (((ob >> 9) & 1) << 5)); }
__host__ __device__ __forceinline__ void stage_rc(int b, int& R, int& C) { const int st = b / 1024, sb = b % 1024, swz = sb ^ (((sb >> 9) & 1) << 5); R = (st >> 1) * 16 + swz / 64; C = (st & 1) * 32 + (swz % 64) / 2; }
__host__ __device__ __forceinline__ int perm32(int rho) { const int n = rho >> 4, i = rho & 15; return 8 * (i >> 2) + 4 * n + (i & 3); }

struct Unit { int pm, pn, e, aux; };
struct Gemm { int K, lda, ldb, pad; };

template <class Epi, class Sched, bool ALIGN_EPI>
__device__ __forceinline__ void gemm_phase(LAS unsigned char* lds, const Gemm g, const Sched& S, const Epi& E) {
    int tid = threadIdx.x; asm volatile("" : "+v"(tid));
    const int wid = __builtin_amdgcn_readfirstlane(tid >> 6), lane = tid & 63, wr = wid >> 2, wc = wid & 3, fr = lane & 15, fq = lane >> 4;
    const int K = g.K; int nt = K / BK; asm volatile("" : "+s"(nt));
    int Rr[2], Cc[2]; unsigned voffB[2];
#pragma unroll
    for (int i = 0; i < 2; ++i) { int R, C; stage_rc(tid * 16 + i * 8192, R, C); Rr[i] = R; Cc[i] = C; const int Rb = Epi::PERM ? ((R & ~31) + perm32(R & 31)) : R;
        voffB[i] = (unsigned)(Rb * g.ldb + C) * 2u; }
    const size_t kstep = (size_t)(BK * 2);
    const size_t hstepB = (size_t)HALF * g.ldb * 2;
    const unsigned ldsw = (unsigned)wid * 1024u;
    const int aoff = lds_byte(wr * 64 + fr, fq * 8), boff = lds_byte(wc * 32 + fr, fq * 8);
#define PG8_SA(b, h) (((b) * 2 + (h)) * HTB)
#define PG8_SB(b, h) ((4 + (b) * 2 + (h)) * HTB)
#define PG8_STAGE(bufoff, gbase, voff) do { _Pragma("unroll") for (int _i = 0; _i < 2; ++_i) \
        __builtin_amdgcn_global_load_lds((const unsigned*)((const char*)(gbase) + (voff)[_i]), (LAS unsigned*)(lds + (bufoff) + ldsw + _i * 8192), 16, 0, 0); } while (0)
#define PG8_LDA(dst, b, h) do { _Pragma("unroll") for (int m = 0; m < 4; ++m) _Pragma("unroll") for (int k = 0; k < 2; ++k) dst[m][k] = *(const LAS bf16x8*)(lds + PG8_SA(b, h) + aoff + m * 2048 + k * 1024); } while (0)
#define PG8_LDB(dst, b, h) do { _Pragma("unroll") for (int n = 0; n < 2; ++n) _Pragma("unroll") for (int k = 0; k < 2; ++k) dst[n][k] = *(const LAS bf16x8*)(lds + PG8_SB(b, h) + boff + n * 2048 + k * 1024); } while (0)
#define PG8_MMA(ai, bj, At, Bt) do { __builtin_amdgcn_s_setprio(1); _Pragma("unroll") for (int m = 0; m < 4; ++m) _Pragma("unroll") for (int n = 0; n < 2; ++n) _Pragma("unroll") for (int k = 0; k < 2; ++k) \
        acc[ai][bj][m][n] = __builtin_amdgcn_mfma_f32_16x16x32_bf16(Bt[n][k], At[m][k], acc[ai][bj][m][n], 0, 0, 0); __builtin_amdgcn_s_setprio(0); } while (0)
#define PG8_WAIT_V(n) asm volatile("s_waitcnt vmcnt(" #n ")" ::: "memory")
#define PG8_WAIT_L(n) asm volatile("s_waitcnt lgkmcnt(" #n ")" ::: "memory")
#define PG8_BAR __builtin_amdgcn_s_barrier()
#define PG8_SCHED __builtin_amdgcn_sched_barrier(0)
#define PG8_VOFF(dst, u) do { _Pragma("unroll") for (int h = 0; h < 2; ++h) _Pragma("unroll") for (int i = 0; i < 2; ++i) \
        dst[h][i] = Sched::GATHER ? (S.a_rowoff(u, h * HALF + Rr[i]) + (unsigned)Cc[i] * 2u) : (unsigned)(Rr[i] * g.lda + Cc[i]) * 2u; } while (0)
    const size_t hstepA = Sched::GATHER ? (size_t)0 : (size_t)HALF * g.lda * 2;
    Unit cur, nxt; int ui = 0;
    if (!S.next(0, cur)) return;
    f32x4 acc[2][2][4][2];
#pragma unroll
    for (int a = 0; a < 2; ++a)
#pragma unroll
        for (int b = 0; b < 2; ++b)
#pragma unroll
            for (int m = 0; m < 4; ++m)
#pragma unroll
                for (int n = 0; n < 2; ++n) acc[a][b][m][n] = (f32x4){0.f, 0.f, 0.f, 0.f};
    bf16x8 At[4][2], B0[2][2], B1[2][2];
    unsigned vA[2][2], nvA[2][2];
    PG8_VOFF(vA, cur);
    const char* cA = S.a_base(cur); const char* cB = S.b_base(cur);
    PG8_STAGE(PG8_SB(0, 0), cB, voffB); PG8_STAGE(PG8_SB(0, 1), cB + hstepB, voffB); PG8_STAGE(PG8_SA(0, 0), cA, vA[0]); PG8_STAGE(PG8_SA(0, 1), cA + hstepA, vA[1]);
    if (wr == 1) PG8_BAR;
    PG8_WAIT_V(2); PG8_BAR;
    PG8_STAGE(PG8_SB(1, 0), cB + kstep, voffB); PG8_STAGE(PG8_SA(1, 0), cA + kstep, vA[0]); PG8_STAGE(PG8_SB(1, 1), cB + hstepB + kstep, voffB);
    PG8_WAIT_V(6); PG8_BAR;
    for (;;) {
        const bool has_next = S.next(ui + 1, nxt);
        const char* nA = cA; const char* nB = cB;
#pragma unroll
        for (int h = 0; h < 2; ++h)
#pragma unroll
            for (int i = 0; i < 2; ++i) nvA[h][i] = vA[h][i];
        if (has_next) { nA = S.a_base(nxt); nB = S.b_base(nxt); PG8_VOFF(nvA, nxt); }
        for (int t = 0; t < nt; t += 2) {
            const bool last = (t == nt - 2);
            const char* a1 = cA + (size_t)(t + 1) * kstep;
            const char* a2 = last ? nA : cA + (size_t)(t + 2) * kstep; const char* b2 = last ? nB : cB + (size_t)(t + 2) * kstep;
            const char* a3 = a2 + kstep; const char* b3 = b2 + kstep;
            unsigned v2[2][2];
#pragma unroll
            for (int h = 0; h < 2; ++h)
#pragma unroll
                for (int i = 0; i < 2; ++i) v2[h][i] = last ? nvA[h][i] : vA[h][i];
            PG8_LDB(B0, 0, 0); PG8_LDB(B1, 0, 1); PG8_SCHED; PG8_LDA(At, 0, 0); PG8_STAGE(PG8_SA(1, 1), a1 + hstepA, vA[1]);
            PG8_WAIT_V(8); PG8_WAIT_L(0); PG8_BAR; PG8_MMA(0, 0, At, B0); PG8_MMA(0, 1, At, B1); PG8_BAR; PG8_SCHED;
            PG8_LDA(At, 0, 1); PG8_STAGE(PG8_SB(0, 0), b2, voffB); PG8_STAGE(PG8_SB(0, 1), b2 + hstepB, voffB); PG8_STAGE(PG8_SA(0, 0), a2, v2[0]);
            PG8_WAIT_V(8); PG8_WAIT_L(0); PG8_BAR; PG8_MMA(1, 0, At, B0); PG8_MMA(1, 1, At, B1); PG8_BAR; PG8_SCHED;
            PG8_LDB(B0, 1, 0); PG8_LDB(B1, 1, 1); PG8_SCHED; PG8_LDA(At, 1, 0); PG8_STAGE(PG8_SA(0, 1), a2 + hstepA, v2[1]);
            PG8_WAIT_V(8); PG8_WAIT_L(0); PG8_BAR; PG8_MMA(0, 0, At, B0); PG8_MMA(0, 1, At, B1); PG8_BAR; PG8_SCHED;
            PG8_LDA(At, 1, 1); PG8_STAGE(PG8_SB(1, 0), b3, voffB); PG8_STAGE(PG8_SB(1, 1), b3 + hstepB, voffB); PG8_STAGE(PG8_SA(1, 0), a3, v2[0]);
            PG8_WAIT_V(8); PG8_WAIT_L(0); PG8_BAR; PG8_MMA(1, 0, At, B0); PG8_MMA(1, 1, At, B1); PG8_BAR; PG8_SCHED;
        }
        if constexpr (ALIGN_EPI) { if (wr == 0) PG8_BAR; }
        E(acc, cur, wr, wc, fr, fq);
        if (!has_next) break;
#pragma unroll
        for (int a = 0; a < 2; ++a)
#pragma unroll
            for (int b = 0; b < 2; ++b)
#pragma unroll
                for (int m = 0; m < 4; ++m)
#pragma unroll
                    for (int n = 0; n < 2; ++n) acc[a][b][m][n] = (f32x4){0.f, 0.f, 0.f, 0.f};
        cur = nxt; cA = nA; cB = nB; ++ui;
#pragma unroll
        for (int h = 0; h < 2; ++h)
#pragma unroll
            for (int i = 0; i < 2; ++i) vA[h][i] = nvA[h][i];
        if constexpr (ALIGN_EPI) { if (wr == 1) PG8_BAR; }
    }
    PG8_WAIT_V(0);
    if constexpr (!ALIGN_EPI) { if (wr == 0) PG8_BAR; }
    PG8_BAR;
#undef PG8_SA
#undef PG8_SB
#undef PG8_STAGE
#undef PG8_LDA
#undef PG8_LDB
#undef PG8_MMA
#undef PG8_WAIT_V
#undef PG8_WAIT_L
#undef PG8_BAR
#undef PG8_SCHED
#undef PG8_VOFF
}
}
namespace fk {
using pg8::Unit;
typedef f32x4 Acc[2][2][4][2];

__device__ __forceinline__ u32x4 pack8(f32x4 a, f32x4 b) { u32x4 w; w.x = cvt_pk_bf16(a[0], a[1]); w.y = cvt_pk_bf16(a[2], a[3]); w.z = cvt_pk_bf16(b[0], b[1]); w.w = cvt_pk_bf16(b[2], b[3]); return w; }

struct SchedStatic {
    static constexpr bool GATHER = false;
    const char* A; const char* Bt; int lda, ldb; int nM, nN, nwg, G, c;
    __device__ __forceinline__ void init(const void* A_, int lda_, const void* Bt_, int ldb_, int Mrows, int N, int G_, int c_) { A = (const char*)A_; Bt = (const char*)Bt_; lda = lda_; ldb = ldb_; nM = Mrows / 256; nN = N / 256; nwg = nM * nN; G = G_; c = c_; }
    __device__ __forceinline__ bool next(int i, Unit& u) const {
        const long L = (long)i * G + c; if (L >= nwg) return false;
        int wgid = (int)L; { const int q = nwg / 8, r = nwg % 8, xcd = wgid % 8, off = wgid / 8; wgid = (xcd < r ? xcd * (q + 1) : r * (q + 1) + (xcd - r) * q) + off; }
        const int nig = 8 * nN, gid = wgid / nig, fm = gid * 8, gsz = (nM - fm) < 8 ? (nM - fm) : 8;
        u.pm = fm + ((wgid % nig) % gsz); u.pn = (wgid % nig) / gsz; u.e = 0; u.aux = 0; return true;
    }
    __device__ __forceinline__ const char* a_base(const Unit& u) const { return A + (size_t)u.pm * 256 * lda * 2; }
    __device__ __forceinline__ const char* b_base(const Unit& u) const { return Bt + (size_t)u.pn * 256 * ldb * 2; }
    __device__ __forceinline__ unsigned a_rowoff(const Unit&, int) const { return 0u; }
};

struct EpiU {
    static constexpr bool PERM = true;
    bf16_t* U;
    __device__ __forceinline__ void operator()(const Acc& acc, const Unit& u, int wr, int wc, int fr, int fq) const {
        asm volatile("" : "+v"(fr), "+v"(fq));
        const float sc = (u.pn == 2 || u.pn == 3) ? QS_DIFF : (u.pn == 8 ? QS_SB : 1.f);
#pragma unroll
        for (int ai = 0; ai < 2; ++ai)
#pragma unroll
            for (int m = 0; m < 4; ++m) { bf16_t* rowp = U + (size_t)(u.pm * 256 + ai * 128 + wr * 64 + m * 16 + fr) * UP + u.pn * 256 + wc * 32 + 8 * fq;
#pragma unroll
                for (int bj = 0; bj < 2; ++bj) *(u32x4*)(rowp + bj * 128) = pack8(acc[ai][bj][m][0] * sc, acc[ai][bj][m][1] * sc); }
    }
};

struct SchedMla {
    static constexpr bool GATHER = false;
    const char* U; const char* Wuq; const char* Wukv; int G, c;
    __device__ __forceinline__ bool next(int i, Unit& u) const { const int L = i * G + c; if (L >= 256) return false; u.e = L >> 7; const int r = L & 127; u.pm = r >> 1; u.pn = r & 1; u.aux = 0; return true; }
    __device__ __forceinline__ const char* a_base(const Unit& u) const { return U + ((size_t)u.pm * 256 * UP + (u.e ? U_CKV : U_CQ)) * 2; }
    __device__ __forceinline__ const char* b_base(const Unit& u) const { return (u.e ? Wukv : Wuq) + (size_t)u.pn * 256 * 256 * 2; }
    __device__ __forceinline__ unsigned a_rowoff(const Unit&, int) const { return 0u; }
};
struct EpiMla {
    static constexpr bool PERM = true;
    bf16_t* MQ; bf16_t* MK; bf16_t* MV; const f32x2* CS; const LAS float* rtab;
    __device__ __forceinline__ void operator()(const Acc& acc, const Unit& u, int wr, int wc, int fr, int fq) const {
        asm volatile("" : "+v"(fr), "+v"(fq));
#pragma unroll
        for (int ai = 0; ai < 2; ++ai)
#pragma unroll
            for (int m = 0; m < 4; ++m) {
                const int rt = ai * 128 + wr * 64 + m * 16 + fr; const size_t row = (size_t)u.pm * 256 + rt;
                const float r = rtab[rt] * (u.e == 0 ? QS_MLA : 1.f);
#pragma unroll
                for (int bj = 0; bj < 2; ++bj) {
                    const int ct = u.pn * 256 + bj * 128 + wc * 32 + 8 * fq;
                    f32x4 v0 = acc[ai][bj][m][0] * r, v1 = acc[ai][bj][m][1] * r;
                    if (u.e == 0) {
                        if (ct < 256) { *(u32x4*)(MQ + row * 384 + (ct >> 6) * 96 + (ct & 63)) = pack8(v0, v1); }
#ifndef NO_ROPE_DBG
                        else if (ct < 384) {
                            const int hh = (ct - 256) >> 5, i0 = (ct - 256) & 31; const bool second = (i0 & 16) != 0; const int ib = i0 & 15;
                            f32x4 o0, o1;
#pragma unroll
                            for (int j = 0; j < 4; ++j) {
                                const float p0 = __shfl_xor(v0[j], 32), p1 = __shfl_xor(v1[j], 32);
                                const f32x2 cs0 = CS[row * 16 + ib + j], cs1 = CS[row * 16 + ib + 4 + j];
                                o0[j] = second ? (p0 * cs0.y + v0[j] * cs0.x) : (v0[j] * cs0.x - p0 * cs0.y);
                                o1[j] = second ? (p1 * cs1.y + v1[j] * cs1.x) : (v1[j] * cs1.x - p1 * cs1.y);
                            }
                            *(u32x4*)(MQ + row * 384 + hh * 96 + 64 + i0) = pack8(o0, o1);
                        }
#endif
                    } else {
                        if (ct < 256) *(u32x4*)(MK + row * 384 + (ct >> 6) * 96 + (ct & 63)) = pack8(v0, v1);
                        else *(u32x4*)(MV + row * 256 + (ct - 256)) = pack8(v0, v1);
                    }
                }
            }
    }
};

struct EpiResid {
    static constexpr bool PERM = false;
    const float* HF; float* T;
    __device__ __forceinline__ void operator()(const Acc& acc, const Unit& u, int wr, int wc, int fr, int fq) const {
        asm volatile("" : "+v"(fr), "+v"(fq));
#pragma unroll
        for (int ai = 0; ai < 2; ++ai)
#pragma unroll
            for (int m = 0; m < 4; ++m) { const size_t off = (size_t)(u.pm * 256 + ai * 128 + wr * 64 + m * 16 + fr) * D + u.pn * 256 + wc * 32 + 4 * fq;
#pragma unroll
                for (int bj = 0; bj < 2; ++bj)
#pragma unroll
                    for (int n = 0; n < 2; ++n) { const f32x4 h = *(const f32x4*)(HF + off + bj * 128 + n * 16); *(f32x4*)(T + off + bj * 128 + n * 16) = h * ALPHA + acc[ai][bj][m][n]; } }
    }
};

struct EpiBf16 {
    static constexpr bool PERM = true;
    bf16_t* O; int ldc; int pad;
    __device__ __forceinline__ void operator()(const Acc& acc, const Unit& u, int wr, int wc, int fr, int fq) const {
        asm volatile("" : "+v"(fr), "+v"(fq));
#pragma unroll
        for (int ai = 0; ai < 2; ++ai)
#pragma unroll
            for (int m = 0; m < 4; ++m) { bf16_t* rowp = O + (size_t)(u.pm * 256 + ai * 128 + wr * 64 + m * 16 + fr) * ldc + u.pn * 256 + wc * 32 + 8 * fq;
#pragma unroll
                for (int bj = 0; bj < 2; ++bj) *(u32x4*)(rowp + bj * 128) = pack8(acc[ai][bj][m][0], acc[ai][bj][m][1]); }
    }
};

struct MoeTiles {
    const LAS int* tab;
    __device__ __forceinline__ static void build(LAS int* t, const gu32* cw) {
        if (threadIdx.x == 0) { int tp = 0, rb = 0;
            for (int e = 0; e < 16; ++e) { const int c = (int)__hip_atomic_load(cw + 64 * e, RLX_AGENT); t[e] = tp; t[32 + e] = rb; t[64 + e] = c; tp += (c + 255) >> 8; rb += c; }
            t[16] = tp; t[48] = rb; }
    }
    __device__ __forceinline__ bool decode(int L, Unit& u) const {
        const int t = L >> 2; if (t >= __builtin_amdgcn_readfirstlane(tab[16])) return false;
        int e = 0;
        for (int k = 1; k < 16; ++k) e = (t >= __builtin_amdgcn_readfirstlane(tab[k])) ? k : e;
        u.e = e; u.pm = t - __builtin_amdgcn_readfirstlane(tab[e]); u.pn = L & 3; u.aux = __builtin_amdgcn_readfirstlane(tab[64 + e]); return true;
    }
    __device__ __forceinline__ int rowbase(int e) const { return __builtin_amdgcn_readfirstlane(tab[32 + e]); }
};
struct SchedMoe1 {
    static constexpr bool GATHER = true;
    MoeTiles T; const char* H1B; const char* Wgu; const int* ltok; int G, c;
    __device__ __forceinline__ bool next(int i, Unit& u) const { return T.decode(i * G + c, u); }
    __device__ __forceinline__ const char* a_base(const Unit&) const { return H1B; }
    __device__ __forceinline__ const char* b_base(const Unit& u) const { return Wgu + ((size_t)u.e * 1024 + u.pn * 256) * 1024 * 2; }
    __device__ __forceinline__ unsigned a_rowoff(const Unit& u, int r) const { const int p = u.pm * 256 + r; const int tok = p < u.aux ? ltok[u.e * M + p] : 0; return (unsigned)tok * (D * 2u); }
};
struct EpiMoe1 {
    static constexpr bool PERM = true;
    MoeTiles T; bf16_t* HID;
    __device__ __forceinline__ void operator()(const Acc& acc, const Unit& u, int wr, int wc, int fr, int fq) const {
        asm volatile("" : "+v"(fr), "+v"(fq));
        const int rb = T.rowbase(u.e);
#pragma unroll
        for (int ai = 0; ai < 2; ++ai)
#pragma unroll
            for (int m = 0; m < 4; ++m) { const int p = u.pm * 256 + ai * 128 + wr * 64 + m * 16 + fr;
                f32x4 h0, h1;
#pragma unroll
                for (int j = 0; j < 4; ++j) { const float g0 = acc[ai][0][m][0][j], g1 = acc[ai][0][m][1][j];
                    h0[j] = g0 * __builtin_amdgcn_rcpf(1.f + __builtin_amdgcn_exp2f(-g0 * LOG2E)) * acc[ai][1][m][0][j];
                    h1[j] = g1 * __builtin_amdgcn_rcpf(1.f + __builtin_amdgcn_exp2f(-g1 * LOG2E)) * acc[ai][1][m][1][j]; }
                if (p < u.aux) *(u32x4*)(HID + (size_t)(rb + p) * 512 + u.pn * 128 + wc * 32 + 8 * fq) = pack8(h0, h1); }
    }
};
struct SchedMoe2 {
    static constexpr bool GATHER = false;
    MoeTiles T; const char* HID; const char* Wd; int G, c;
    __device__ __forceinline__ bool next(int i, Unit& u) const { return T.decode(i * G + c, u); }
    __device__ __forceinline__ const char* a_base(const Unit& u) const { return HID + (size_t)(T.rowbase(u.e) + u.pm * 256) * 512 * 2; }
    __device__ __forceinline__ const char* b_base(const Unit& u) const { return Wd + ((size_t)u.e * 1024 + u.pn * 256) * 512 * 2; }
    __device__ __forceinline__ unsigned a_rowoff(const Unit&, int) const { return 0u; }
};
struct EpiMoe2 {
    static constexpr bool PERM = true;
    bf16_t* FFN; const int* lslot; const float* lw;
    __device__ __forceinline__ void operator()(const Acc& acc, const Unit& u, int wr, int wc, int fr, int fq) const {
        asm volatile("" : "+v"(fr), "+v"(fq));
#pragma unroll
        for (int ai = 0; ai < 2; ++ai)
#pragma unroll
            for (int m = 0; m < 4; ++m) { const int p = u.pm * 256 + ai * 128 + wr * 64 + m * 16 + fr;
                if (p < u.aux) { const int slot = lslot[u.e * M + p]; const float w = lw[u.e * M + p];
                    bf16_t* rowp = FFN + (size_t)slot * D + u.pn * 256 + wc * 32 + 8 * fq;
#pragma unroll
                    for (int bj = 0; bj < 2; ++bj) *(u32x4*)(rowp + bj * 128) = pack8(acc[ai][bj][m][0] * w, acc[ai][bj][m][1] * w); } }
    }
};
struct EpiPle {
    static constexpr bool PERM = false;
    const float* H1F; const bf16_t* PP; float* T2;
    __device__ __forceinline__ void operator()(const Acc& acc, const Unit& u, int wr, int wc, int fr, int fq) const {
        asm volatile("" : "+v"(fr), "+v"(fq));
#pragma unroll
        for (int ai = 0; ai < 2; ++ai)
#pragma unroll
            for (int m = 0; m < 4; ++m) { const size_t off = (size_t)(u.pm * 256 + ai * 128 + wr * 64 + m * 16 + fr) * D + u.pn * 256 + wc * 32 + 4 * fq;
#pragma unroll
                for (int bj = 0; bj < 2; ++bj)
#pragma unroll
                    for (int n = 0; n < 2; ++n) { const size_t o = off + bj * 128 + n * 16; const f32x4 h = *(const f32x4*)(H1F + o); const u32x2 pw = *(const u32x2*)(PP + o);
                        const f32x4 a = acc[ai][bj][m][n]; f32x4 r;
                        r[0] = h[0] * ALPHA + bflo(pw.x) * __builtin_amdgcn_rcpf(1.f + __builtin_amdgcn_exp2f(-a[0] * LOG2E));
                        r[1] = h[1] * ALPHA + bfhi(pw.x) * __builtin_amdgcn_rcpf(1.f + __builtin_amdgcn_exp2f(-a[1] * LOG2E));
                        r[2] = h[2] * ALPHA + bflo(pw.y) * __builtin_amdgcn_rcpf(1.f + __builtin_amdgcn_exp2f(-a[2] * LOG2E));
                        r[3] = h[3] * ALPHA + bfhi(pw.y) * __builtin_amdgcn_rcpf(1.f + __builtin_amdgcn_exp2f(-a[3] * LOG2E));
                        *(f32x4*)(T2 + o) = r; } }
    }
};
}
namespace fk {
#define LDS_WAIT() asm volatile("s_waitcnt lgkmcnt(0)" ::: "memory")
#define VM_WAIT() asm volatile("s_waitcnt vmcnt(0)" ::: "memory")
#define WAIT_ALL_BAR() asm volatile("s_waitcnt vmcnt(0) lgkmcnt(0)\n\ts_barrier" ::: "memory")

constexpr int AT_KSLOT = 12288, AT_VSLOT = 16384;
constexpr int AT_K = 0, AT_V = 2 * AT_KSLOT, AT_WS = AT_V + 2 * AT_VSLOT, AT_BIAS = AT_WS + 8 * 256, AT_UID = AT_BIAS + 256, AT_KP = AT_UID + 256, AT_END = AT_KP + 8 * 256;

__device__ __forceinline__ void glds16(const void* gsrc, unsigned lds_dst) { unsigned keep;
    asm volatile("s_mov_b32 %0, m0\n\ts_mov_b32 m0, %2\n\ts_nop 0\n\tglobal_load_lds_dwordx4 %1, off\n\ts_mov_b32 m0, %0" : "=&s"(keep) : "v"(gsrc), "s"(lds_dst) : "memory"); }
__device__ __forceinline__ int crow(int r, int hi) { return (r & 3) + 8 * (r >> 2) + 4 * hi; }
__device__ __forceinline__ int t5_bucket(int rel) {
    const int side = rel > 0 ? 16 : 0; const int n = rel < 0 ? -rel : rel;
    int v = n;
    v = n >= 8 ? 8 : v; v = n >= 12 ? 9 : v; v = n >= 16 ? 10 : v; v = n >= 23 ? 11 : v; v = n >= 32 ? 12 : v; v = n >= 46 ? 13 : v; v = n >= 64 ? 14 : v; v = n >= 91 ? 15 : v;
    return side + v;
}

template <int NDV>
__device__ __forceinline__ void pv(f32x16* o, int vb, bf16x8 pa0, bf16x8 pa1, bf16x8 pa2, bf16x8 pa3) {
#pragma unroll
    for (int d0 = 0; d0 < NDV; ++d0) { s16x4 lo[4], hi[4];
#pragma unroll
        for (int ks = 0; ks < 4; ++ks) {
            asm volatile("ds_read_b64_tr_b16 %0,%1 offset:%c2" : "=&v"(lo[ks]) : "v"(vb), "i"(d0 * 4096 + ks * 1024) : "memory");
            asm volatile("ds_read_b64_tr_b16 %0,%1 offset:%c2" : "=&v"(hi[ks]) : "v"(vb), "i"(d0 * 4096 + ks * 1024 + 512) : "memory"); }
        asm volatile("s_waitcnt lgkmcnt(0)" ::: "memory"); __builtin_amdgcn_sched_barrier(0);
#define PKV(k) (bf16x8){lo[k][0], lo[k][1], lo[k][2], lo[k][3], hi[k][0], hi[k][1], hi[k][2], hi[k][3]}
        o[d0] = __builtin_amdgcn_mfma_f32_32x32x16_bf16(pa0, PKV(0), o[d0], 0, 0, 0);
        o[d0] = __builtin_amdgcn_mfma_f32_32x32x16_bf16(pa1, PKV(1), o[d0], 0, 0, 0);
        o[d0] = __builtin_amdgcn_mfma_f32_32x32x16_bf16(pa2, PKV(2), o[d0], 0, 0, 0);
        o[d0] = __builtin_amdgcn_mfma_f32_32x32x16_bf16(pa3, PKV(3), o[d0], 0, 0, 0);
#undef PKV
    }
}

template <int NDQ, int NDV, bool BIAS>
__device__ __forceinline__ void attn_unit(LAS unsigned char* lds, const bf16_t* Q, int qp, const bf16_t* K, int kp, const bf16_t* V, int vp, bf16_t* O, int op,
                                          int b, int qb, const int* pos, const int* pmm, const float* relb  ) {
    int tid = threadIdx.x; asm volatile("" : "+v"(tid));
    const int lane = tid & 63, r32 = lane & 31, hi = lane >> 5; const int wid = __builtin_amdgcn_readfirstlane(tid >> 6);
    const unsigned lds0 = (unsigned)(uintptr_t)lds;
    const size_t rowbase = (size_t)b * SEQ; const int q0 = qb * 256;
    const int NT = q0 / 64 + 4, tv = q0 / 64 + (wid >> 1);
    constexpr int NPK = 2 * NDQ, NPV = 4 * NDV, NP = NPK + NPV;
    LAS float* wsf = (LAS float*)(lds + AT_WS) + wid * 64;
    LAS float* blds = (LAS float*)(lds + AT_BIAS);
#define AT_ISSUE(t, s) do { _Pragma("unroll") for (int j_ = 0; j_ < 3; ++j_) { const int p_ = wid + 8 * j_; if (p_ < NP) { \
        const bf16_t* src_; unsigned dst_; \
        if (p_ < NPK) { src_ = K + (rowbase + (size_t)(t) * 64 + lane) * kp + p_ * 8; dst_ = lds0 + AT_K + (s) * AT_KSLOT + p_ * 1024; } \
        else { const int v_ = p_ - NPK; src_ = V + (rowbase + (size_t)(t) * 64 + (v_ & 3) * 16 + (lane >> 2)) * vp + (v_ >> 2) * 32 + (lane & 3) * 8; dst_ = lds0 + AT_V + (s) * AT_VSLOT + v_ * 1024; } \
        glds16(src_, (unsigned)__builtin_amdgcn_readfirstlane(dst_)); } } } while (0)
    AT_ISSUE(0, 0);
    const bf16_t* Qw = Q + (rowbase + q0 + wid * 32 + r32) * qp;
    bf16x8 qr[NDQ];
#pragma unroll
    for (int d0 = 0; d0 < NDQ; ++d0) qr[d0] = *(const bf16x8*)(Qw + d0 * 16 + hi * 8);
    int qpos = 0, qmn = 0, qmx = 0;
    if (BIAS) {
        qpos = pos[rowbase + q0 + wid * 32 + r32]; qmn = qpos; qmx = qpos;
#pragma unroll
        for (int o_ = 1; o_ < 32; o_ <<= 1) { qmn = min(qmn, __shfl_xor(qmn, o_)); qmx = max(qmx, __shfl_xor(qmx, o_)); }
        if (tid < 32) blds[tid] = relb[tid * 4] * LOG2E;
    }
    f32x16 o[NDV];
#pragma unroll
    for (int d = 0; d < NDV; ++d)
#pragma unroll
        for (int r = 0; r < 16; ++r) o[d][r] = 0.f;
    float mhat = 0.f, l = 0.f;
    WAIT_ALL_BAR();
    for (int t = 0; t < NT; ++t) {
        const int s = t & 1;
        if (t + 1 < NT) AT_ISSUE(t + 1, s ^ 1);
        if (t <= tv) {
            float cb = 0.f; bool nearb = false;
            if (BIAS) { const int kmn = pmm[(b * 128 + t) * 2], kmx = pmm[(b * 128 + t) * 2 + 1];
                if (kmx - qmn <= -128) cb = blds[15]; else if (kmn - qmx >= 128) cb = blds[31]; else nearb = true; }
            const float ci = cb - mhat;
            f32x16 p0, p1;
#pragma unroll
            for (int r = 0; r < 16; ++r) { p0[r] = ci; p1[r] = ci; }
            const LAS unsigned char* kb = lds + AT_K + s * AT_KSLOT + hi * 1024 + r32 * 16;
#pragma unroll
            for (int d0 = 0; d0 < NDQ; ++d0) {
                const bf16x8 b0 = *(const LAS bf16x8*)(kb + d0 * 2048), b1 = *(const LAS bf16x8*)(kb + d0 * 2048 + 512);
                p0 = __builtin_amdgcn_mfma_f32_32x32x16_bf16(b0, qr[d0], p0, 0, 0, 0);
                p1 = __builtin_amdgcn_mfma_f32_32x32x16_bf16(b1, qr[d0], p1, 0, 0, 0);
            }
            if (BIAS && nearb) {
                LAS int* kpl = (LAS int*)(lds + AT_KP) + wid * 64;
                kpl[lane] = pos[rowbase + t * 64 + lane];
                LDS_WAIT();
#pragma unroll
                for (int r = 0; r < 16; ++r) { const int kk = crow(r, hi);
                    p0[r] += blds[t5_bucket(kpl[kk] - qpos)]; p1[r] += blds[t5_bucket(kpl[kk + 32] - qpos)];
                    if ((r & 3) == 3) __builtin_amdgcn_sched_barrier(0); }
            }
            float rm = fmaxf(p0[0], p1[0]);
#pragma unroll
            for (int r = 1; r < 16; ++r) rm = fmaxf(rm, fmaxf(p0[r], p1[r]));
            rm = fmaxf(rm, __shfl_xor(rm, 32));
            if (t == 0) {
                mhat = rm;
#pragma unroll
                for (int r = 0; r < 16; ++r) { p0[r] -= rm; p1[r] -= rm; }
            } else if (__any(rm > 8.f)) {
                const float dl = fmaxf(rm, 0.f); mhat += dl;
#pragma unroll
                for (int r = 0; r < 16; ++r) { p0[r] -= dl; p1[r] -= dl; }
                const float f = __builtin_amdgcn_exp2f(-dl); l *= f;
                if (hi == 0) wsf[r32] = f;
                LDS_WAIT();
#pragma unroll
                for (int r = 0; r < 16; ++r) { const float fr_ = wsf[crow(r, hi)];
#pragma unroll
                    for (int d = 0; d < NDV; ++d) o[d][r] *= fr_; }
            }
            float sacc = 0.f;
#pragma unroll
            for (int r = 0; r < 16; ++r) { p0[r] = __builtin_amdgcn_exp2f(p0[r]); p1[r] = __builtin_amdgcn_exp2f(p1[r]); sacc += p0[r] + p1[r]; }
            l += sacc;
            u32x4 pw0, pw1, pw2, pw3;
            pw0 = (u32x4){cvt_pk_bf16(p0[0], p0[1]), cvt_pk_bf16(p0[2], p0[3]), cvt_pk_bf16(p0[4], p0[5]), cvt_pk_bf16(p0[6], p0[7])};
            pw1 = (u32x4){cvt_pk_bf16(p0[8], p0[9]), cvt_pk_bf16(p0[10], p0[11]), cvt_pk_bf16(p0[12], p0[13]), cvt_pk_bf16(p0[14], p0[15])};
            pw2 = (u32x4){cvt_pk_bf16(p1[0], p1[1]), cvt_pk_bf16(p1[2], p1[3]), cvt_pk_bf16(p1[4], p1[5]), cvt_pk_bf16(p1[6], p1[7])};
            pw3 = (u32x4){cvt_pk_bf16(p1[8], p1[9]), cvt_pk_bf16(p1[10], p1[11]), cvt_pk_bf16(p1[12], p1[13]), cvt_pk_bf16(p1[14], p1[15])};
            const int vb = (int)(lds0 + AT_V + s * AT_VSLOT) + ((lane >> 4) & 1) * 32 + (lane & 3) * 8 + (4 * hi + ((lane & 15) >> 2)) * 64;
            pv<NDV>(o, vb, __builtin_bit_cast(bf16x8, pw0), __builtin_bit_cast(bf16x8, pw1), __builtin_bit_cast(bf16x8, pw2), __builtin_bit_cast(bf16x8, pw3));
        }
        WAIT_ALL_BAR();
    }
#undef AT_ISSUE
    const float lt = l + __shfl_xor(l, 32);
    if (hi == 0) wsf[32 + r32] = __builtin_amdgcn_rcpf(lt);
    LDS_WAIT();
    int hi2 = hi, r32b = r32; asm volatile("" : "+v"(hi2), "+v"(r32b));
    bf16_t* Ow = O + (rowbase + q0 + wid * 32) * op + r32b;
#pragma unroll
    for (int r = 0; r < 16; ++r) { const int qr_ = crow(r, hi2); const float rl = wsf[32 + qr_];
#pragma unroll
        for (int d = 0; d < NDV; ++d) { const unsigned w = cvt_pk_bf16(o[d][r] * rl, 0.f); Ow[(size_t)qr_ * op + d * 32] = (bf16_t)(w & 0xffffu); } }
    WAIT_ALL_BAR();
}

__device__ __forceinline__ void sb_task(const bf16_t* U, bf16_t* MIX, int task, int lane) {
    asm volatile("" : "+v"(lane));
    const int c = task & 127, h = (task >> 7) & 3, b = task >> 9;
    const int qi = c * 64 + lane; const size_t m = (size_t)b * SEQ + qi;
    float qv[64], o[64];
    { const u32x4* qp = (const u32x4*)(U + m * UP + U_SQ + h * 64);
#pragma unroll
      for (int i = 0; i < 8; ++i) { const u32x4 w = qp[i]; qv[8 * i] = bflo(w.x); qv[8 * i + 1] = bfhi(w.x); qv[8 * i + 2] = bflo(w.y); qv[8 * i + 3] = bfhi(w.y); qv[8 * i + 4] = bflo(w.z); qv[8 * i + 5] = bfhi(w.z); qv[8 * i + 6] = bflo(w.w); qv[8 * i + 7] = bfhi(w.w); } }
#pragma unroll
    for (int d = 0; d < 64; ++d) o[d] = 0.f;
    float carry = 0.f;
    for (int j = c * 64 + 63; j >= 0; --j) {
        const u32x4* kp = (const u32x4*)(U + ((size_t)b * SEQ + j) * UP + U_SK + h * 64); const u32x4* vp = (const u32x4*)(U + ((size_t)b * SEQ + j) * UP + U_SV + h * 64);
        float z = 0.f;
#pragma unroll
        for (int i = 0; i < 8; ++i) { const u32x4 w = kp[i];
            z += qv[8 * i] * bflo(w.x) + qv[8 * i + 1] * bfhi(w.x) + qv[8 * i + 2] * bflo(w.y) + qv[8 * i + 3] * bfhi(w.y) + qv[8 * i + 4] * bflo(w.z) + qv[8 * i + 5] * bfhi(w.z) + qv[8 * i + 6] * bflo(w.w) + qv[8 * i + 7] * bfhi(w.w); }
        const float tt = __builtin_amdgcn_logf(1.f + __builtin_amdgcn_exp2f(-fabsf(z)));
        const float ls = fminf(z, 0.f) - tt, lf = fminf(-z, 0.f) - tt;
        const bool valid = j < qi;
        const float w = valid ? __builtin_amdgcn_exp2f(ls + carry) : 0.f;
        carry += valid ? lf : 0.f;
#pragma unroll
        for (int i = 0; i < 8; ++i) { const u32x4 x = vp[i];
            o[8 * i] += w * bflo(x.x); o[8 * i + 1] += w * bfhi(x.x); o[8 * i + 2] += w * bflo(x.y); o[8 * i + 3] += w * bfhi(x.y); o[8 * i + 4] += w * bflo(x.z); o[8 * i + 5] += w * bfhi(x.z); o[8 * i + 6] += w * bflo(x.w); o[8 * i + 7] += w * bfhi(x.w); }
        if (__all(carry < -152.f)) break;
    }
    u32x4* op = (u32x4*)(MIX + m * D + 768 + h * 64);
#pragma unroll
    for (int i = 0; i < 8; ++i) { u32x4 w; w.x = cvt_pk_bf16(o[8 * i], o[8 * i + 1]); w.y = cvt_pk_bf16(o[8 * i + 2], o[8 * i + 3]); w.z = cvt_pk_bf16(o[8 * i + 4], o[8 * i + 5]); w.w = cvt_pk_bf16(o[8 * i + 6], o[8 * i + 7]); op[i] = w; }
}

__device__ __forceinline__ void xpose_item(const float* W, int ldw, int Ksrc, int sc0, const float* gain, bf16_t* WT, int Kdst, int n0, int k0, LAS float* scr, int lane) {
#pragma unroll 8
    for (int i = 0; i < 32; ++i) { const int kk = 2 * i + (lane >> 5), k = k0 + kk; float v = 0.f;
        if (sc0 >= 0 && k < Ksrc) { v = W[(size_t)k * ldw + sc0 + (lane & 31)]; if (gain) v *= gain[k]; }
        scr[kk * 33 + (lane & 31)] = v; }
    LDS_WAIT(); asm volatile("" ::: "memory");
    const int c = lane & 7;
#pragma unroll
    for (int j = 0; j < 4; ++j) { const int n = (lane >> 3) + 8 * j; const LAS float* s = scr + (8 * c) * 33 + n;
        u32x4 o; o.x = cvt_pk_bf16(s[0 * 33], s[1 * 33]); o.y = cvt_pk_bf16(s[2 * 33], s[3 * 33]); o.z = cvt_pk_bf16(s[4 * 33], s[5 * 33]); o.w = cvt_pk_bf16(s[6 * 33], s[7 * 33]);
        *(u32x4*)(WT + (size_t)(n0 + n) * Kdst + k0 + 8 * c) = o; }
    LDS_WAIT(); asm volatile("" ::: "memory");
}
}
namespace fk {
constexpr size_t MiB = 1u << 20;
constexpr size_t WS_CTL = 0, CTL_ZERO_BYTES = 1 * MiB;
constexpr size_t WS_LTOK = 1 * MiB, WS_LSLOT = 2 * MiB, WS_LW = 3 * MiB;
constexpr size_t WS_CS = 4 * MiB;
constexpr size_t WS_PMM = 6 * MiB;
constexpr size_t WS_PB = 7 * MiB;
constexpr size_t WS_W = 16 * MiB;
constexpr size_t W_IN = WS_W, W_UQ = W_IN + (size_t)UP * D * 2, W_UKV = W_UQ + 512 * 256 * 2, W_O = W_UKV + 512 * 256 * 2, W_GU = W_O + (size_t)D * D * 2,
                 W_D = W_GU + (size_t)16 * 1024 * 1024 * 2, W_PG = W_D + (size_t)16 * 1024 * 512 * 2, W_PP = W_PG + (size_t)D * D * 2, W_END_ = W_PP + (size_t)1024 * 256 * 2;
static_assert(W_END_ <= 76 * MiB, "weights region");
constexpr size_t WS_XB = 76 * MiB;
constexpr size_t WS_RA = 108 * MiB;
constexpr size_t WS_U = WS_RA, WS_MQ = WS_RA + 88 * MiB, WS_MK = WS_MQ + 12 * MiB, WS_MV = WS_MK + 12 * MiB, WS_D1 = WS_MV + 8 * MiB, WS_D2 = WS_D1 + 16 * MiB;
constexpr size_t WS_T = WS_RA, WS_HID = WS_RA + 64 * MiB, WS_PPO = WS_RA + 96 * MiB;
constexpr size_t WS_MIX = 260 * MiB;
constexpr size_t WS_FFN = 260 * MiB;
constexpr size_t WS_END = 324 * MiB;
static_assert(WS_D2 + 16 * MiB == WS_MIX && WS_HID + 32 * MiB == WS_PPO && WS_PPO + 32 * MiB <= WS_MIX, "ws map");
constexpr int CW_TMO = 0, CW_BAR = 4096, CW_Q = 8192  , CW_CNT = 8448  , CW_CHK = 16384;
constexpr int RING_BYTES = 131072, LDSX_OFF = RING_BYTES  , MISC_OFF = RING_BYTES + 4096, LDS_BYTES = 147456;
constexpr int NWAVES = 8;

#define XB_TMO      128
#define XB_XCNT(j)  (256  + 64 * (j))
#define XB_XSUB(j)  (1280 + 64 * (j))
#define XB_XGEN(j)  (2304 + 64 * (j))
#define XB_TOP      3328
#define XB_TOPGEN   3392
#define XCD_BAR_WORDS 3456
#define XB_SPIN_CAP (1u << 18)
__device__ __forceinline__ unsigned xb_ld(unsigned* p)              { return __hip_atomic_load(p, __ATOMIC_RELAXED, __HIP_MEMORY_SCOPE_AGENT); }
__device__ __forceinline__ unsigned xb_add(unsigned* p, unsigned v) { return __hip_atomic_fetch_add(p, v, __ATOMIC_RELAXED, __HIP_MEMORY_SCOPE_AGENT); }
__device__ __forceinline__ unsigned xb_xcc_id() { return (unsigned)__builtin_amdgcn_s_getreg((3 << 11) | 20) & 0xFu; }
#define XB_SPIN(cond, bar) do { unsigned _sp = 0; while (cond) { __builtin_amdgcn_s_sleep(1); \
    if ((++_sp & 255u) == 0u) { if (xb_ld(&(bar)[XB_TMO])) break; if (_sp > XB_SPIN_CAP) { atomicAdd(&(bar)[XB_TMO], 1u); break; } } } } while (0)
struct XcdBarrier { unsigned* bar; unsigned x; volatile LAS unsigned* st; };
__device__ __forceinline__ XcdBarrier xcd_barrier_post(unsigned* bar, volatile LAS unsigned* st) {
    XcdBarrier b; b.bar = bar; b.x = xb_xcc_id(); b.st = st;
    if (threadIdx.x == 0) (void)xb_add(&bar[XB_XCNT(b.x)], 1u);
    return b;
}
__device__ __forceinline__ void xcd_barrier_complete(unsigned* bar, unsigned x, unsigned& nloc, unsigned& nx) {
    const unsigned G = gridDim.x * gridDim.y * gridDim.z;
    unsigned sum, cnt, mine, sp = 0u;
    for (;;) {
        sum = 0u; cnt = 0u; mine = 0u;
#pragma unroll
        for (unsigned j = 0; j < 16; ++j) { const unsigned c = xb_ld(&bar[XB_XCNT(j)]); sum += c; cnt += (c > 0u) ? 1u : 0u; mine = (j == x) ? c : mine; }
        if (sum == G) break;
        __builtin_amdgcn_s_sleep(1);
        if ((++sp & 255u) == 0u) { if (xb_ld(&bar[XB_TMO])) break; if (sp > XB_SPIN_CAP) { atomicAdd(&bar[XB_TMO], 1u); break; } }
    }
    nloc = mine > 0u ? mine : 1u; nx = cnt > 0u ? cnt : 1u;
}
__device__ __forceinline__ void xcd_barrier(const XcdBarrier& b) {
    asm volatile("s_waitcnt vmcnt(0)" ::: "memory");
    __syncthreads();
    if (threadIdx.x == 0) {
        unsigned* bar = b.bar;
        __builtin_amdgcn_s_waitcnt(0);
        unsigned nloc = b.st[0], nx = b.st[1];
        if (nloc == 0u) { xcd_barrier_complete(bar, b.x, nloc, nx); b.st[0] = nloc; b.st[1] = nx; }
        const unsigned old = xb_add(&bar[XB_XSUB(b.x)], 1u);
        const unsigned gen = old / nloc;
        if (old + 1u == (gen + 1u) * nloc) {
            __builtin_amdgcn_fence(__ATOMIC_RELEASE, "agent");
            asm volatile("s_waitcnt vmcnt(0)" ::: "memory");
            const unsigned og = xb_add(&bar[XB_TOP], 1u);
            const unsigned tg = og / nx;
            if (og + 1u == (tg + 1u) * nx) xb_add(&bar[XB_TOPGEN], 1u);
            else XB_SPIN(xb_ld(&bar[XB_TOPGEN]) == tg, bar);
            __builtin_amdgcn_fence(__ATOMIC_ACQUIRE, "agent");
            xb_add(&bar[XB_XGEN(b.x)], 1u);
            asm volatile("s_waitcnt vmcnt(0)" ::: "memory");
        } else {
            XB_SPIN(xb_ld(&bar[XB_XGEN(b.x)]) == gen, bar);
            __builtin_amdgcn_fence(__ATOMIC_ACQUIRE, "agent");
            asm volatile("s_waitcnt vmcnt(0)" ::: "memory");
        }
    }
    __syncthreads();
}

struct Args { const void* in[26]; float* out; unsigned char* ws; int ph_lo, ph_hi, use_bar, pad; };
typedef const __attribute__((address_space(4))) Args CArgs;
constexpr int PH_PER_LAYER = 10, N_PHASES = 2 * PH_PER_LAYER;

__device__ __forceinline__ void phase_prologue(CArgs& a, int layer, LAS unsigned char* lds, int gw, int NGW, int lane) {
    unsigned char* ws = a.ws;
    LAS float* scr = (LAS float*)(lds + (gw & 7) * 16384);
    const float* w_in = (const float*)a.in[3] + (size_t)layer * D * 2656; const float* qn = (const float*)a.in[4] + layer * 192; const float* w_uq = (const float*)a.in[5] + (size_t)layer * 192 * 384;
    const float* kvn = (const float*)a.in[6] + layer * 128; const float* w_ukv = (const float*)a.in[7] + (size_t)layer * 128 * 512; const float* w_o = (const float*)a.in[14] + (size_t)layer * D * D;
    const float* wg = (const float*)a.in[19] + (size_t)layer * 16 * D * 512; const float* wu = (const float*)a.in[20] + (size_t)layer * 16 * D * 512; const float* wd = (const float*)a.in[21] + (size_t)layer * 16 * 512 * D;
    const float* pproj = (const float*)a.in[22] + (size_t)layer * 256 * D; const float* pgate = (const float*)a.in[23] + (size_t)layer * D * D;
    constexpr int I_IN = 16 * 88, I_UQ = 4 * 16, I_UKV = 4 * 16, I_O = 16 * 32, I_GU = 16 * 16 * 32, I_D = 16 * 8 * 32, I_PG = 16 * 32, I_PP = 4 * 32;
    constexpr int NITEMS = I_IN + I_UQ + I_UKV + I_O + I_GU + I_D + I_PG + I_PP;
    for (int it = gw; it < NITEMS; it += NGW) {
        int r = it;
        if (r < I_IN) { const int kb = r / 88, nb = r % 88, n0 = nb * 32;
            const int sc = n0 < 192 ? n0 : n0 < 256 ? -1 : n0 < 384 ? 192 + (n0 - 256) : n0 < 416 ? 320 + (n0 - 384) : n0 < 512 ? -1 : 352 + (n0 - 512);
            xpose_item(w_in, 2656, D, sc, nullptr, (bf16_t*)(ws + W_IN), D, n0, kb * 64, scr, lane); continue; } r -= I_IN;
        if (r < I_UQ) { const int kb = r / 16, nb = r % 16, n0 = nb * 32;
            const int sc = n0 < 256 ? (n0 >> 6) * 96 + (n0 & 63) : n0 < 384 ? ((n0 - 256) >> 5) * 96 + 64 : -1;
            xpose_item(w_uq, 384, 192, sc, qn, (bf16_t*)(ws + W_UQ), 256, n0, kb * 64, scr, lane); continue; } r -= I_UQ;
        if (r < I_UKV) { const int kb = r / 16, nb = r % 16, n0 = nb * 32;
            const int sc = n0 < 256 ? (n0 >> 6) * 128 + (n0 & 63) : ((n0 - 256) >> 6) * 128 + 64 + ((n0 - 256) & 63);
            xpose_item(w_ukv, 512, 128, sc, kvn, (bf16_t*)(ws + W_UKV), 256, n0, kb * 64, scr, lane); continue; } r -= I_UKV;
        if (r < I_O) { const int kb = r / 32, nb = r % 32; xpose_item(w_o, D, D, nb * 32, nullptr, (bf16_t*)(ws + W_O), D, nb * 32, kb * 64, scr, lane); continue; } r -= I_O;
        if (r < I_GU) { const int e = r / 512, q = r % 512, kb = q / 32, nb = q % 32, n0 = nb * 32, pn = n0 >> 8, j = n0 & 255;
            const float* src = (j < 128 ? wg : wu) + (size_t)e * D * 512; const int sc = pn * 128 + (j & 127);
            xpose_item(src, 512, D, sc, nullptr, (bf16_t*)(ws + W_GU) + (size_t)e * 1024 * 1024, D, n0, kb * 64, scr, lane); continue; } r -= I_GU;
        if (r < I_D) { const int e = r / 256, q = r % 256, kb = q / 32, nb = q % 32;
            xpose_item(wd + (size_t)e * 512 * D, D, 512, nb * 32, nullptr, (bf16_t*)(ws + W_D) + (size_t)e * 1024 * 512, 512, nb * 32, kb * 64, scr, lane); continue; } r -= I_D;
        if (r < I_PG) { const int kb = r / 32, nb = r % 32; xpose_item(pgate, D, D, nb * 32, nullptr, (bf16_t*)(ws + W_PG), D, nb * 32, kb * 64, scr, lane); continue; } r -= I_PG;
        { const int kb = r / 32, nb = r % 32; xpose_item(pproj, D, 256, nb * 32, nullptr, (bf16_t*)(ws + W_PP), 256, nb * 32, kb * 64, scr, lane); }
    }
    { const f32x4* src = (const f32x4*)((const float*)a.in[1] + (size_t)layer * M * 256); u32x2* dst = (u32x2*)(ws + WS_PB);
      for (int i = gw; i < M * 256 / 256; i += NGW) { const f32x4 v = src[(size_t)i * 64 + lane]; u32x2 w; w.x = cvt_pk_bf16(v[0], v[1]); w.y = cvt_pk_bf16(v[2], v[3]); dst[(size_t)i * 64 + lane] = w; } }
    if (layer == 0) {
        const f32x4* xs = (const f32x4*)a.in[0]; u32x2* xb = (u32x2*)(ws + WS_XB);
        for (int i = gw; i < M * D / 256; i += NGW) { const f32x4 v = xs[(size_t)i * 64 + lane]; u32x2 w; w.x = cvt_pk_bf16(v[0], v[1]); w.y = cvt_pk_bf16(v[2], v[3]); xb[(size_t)i * 64 + lane] = w; }
        const int* pos = (const int*)a.in[2]; f32x2* CS = (f32x2*)(ws + WS_CS);
        for (int i = gw; i < M * 16 / 64; i += NGW) { const int idx = i * 64 + lane, m = idx >> 4, k = idx & 15;
            const float inv = powf(10000.f, -(float)k / 16.f); const float ang = (float)pos[m] * inv; f32x2 cs; cs.x = cosf(ang); cs.y = sinf(ang); CS[idx] = cs; }
        int* pmm = (int*)(ws + WS_PMM);
        for (int i = gw; i < BATCH * 128; i += NGW) { int v = pos[i * 64 + lane], mn = v, mx = v;
#pragma unroll
            for (int o_ = 1; o_ < 64; o_ <<= 1) { mn = min(mn, __shfl_xor(mn, o_)); mx = max(mx, __shfl_xor(mx, o_)); }
            if (lane == 0) { pmm[2 * i] = mn; pmm[2 * i + 1] = mx; } }
    }
}

__device__ __forceinline__ void phase_combine(CArgs& a, int layer, int gw, int NGW, int lane) {
    const float* lq1 = (const float*)a.in[8] + layer * 64; const float* lk1 = (const float*)a.in[9] + layer * 64; const float* lq2 = (const float*)a.in[10] + layer * 64; const float* lk2 = (const float*)a.in[11] + layer * 64;
    const float* subln = (const float*)a.in[12] + layer * 128;
    const float lam_init = layer == 0 ? 0.2f : 0.35550906759f;
    const float lam = __expf(wave_sum(lq1[lane] * lk1[lane])) - __expf(wave_sum(lq2[lane] * lk2[lane])) + lam_init;
    const bf16_t* D1 = (const bf16_t*)(a.ws + WS_D1); const bf16_t* D2 = (const bf16_t*)(a.ws + WS_D2); bf16_t* MIX = (bf16_t*)(a.ws + WS_MIX);
    float g[8];
#pragma unroll
    for (int j = 0; j < 8; ++j) g[j] = subln[(lane & 15) * 8 + j] * (1.f - lam_init);
    for (int m = gw; m < M; m += NGW) {
        const u32x4 a1 = *(const u32x4*)(D1 + (size_t)m * 512 + lane * 8), a2 = *(const u32x4*)(D2 + (size_t)m * 512 + lane * 8);
        float v[8];
        v[0] = bflo(a1.x) - lam * bflo(a2.x); v[1] = bfhi(a1.x) - lam * bfhi(a2.x); v[2] = bflo(a1.y) - lam * bflo(a2.y); v[3] = bfhi(a1.y) - lam * bfhi(a2.y);
        v[4] = bflo(a1.z) - lam * bflo(a2.z); v[5] = bfhi(a1.z) - lam * bfhi(a2.z); v[6] = bflo(a1.w) - lam * bflo(a2.w); v[7] = bfhi(a1.w) - lam * bfhi(a2.w);
        float q = 0.f;
#pragma unroll
        for (int j = 0; j < 8; ++j) q += v[j] * v[j];
        q += __shfl_xor(q, 1); q += __shfl_xor(q, 2); q += __shfl_xor(q, 4); q += __shfl_xor(q, 8);
        const float r = rsqrtf(q * (1.f / 128.f) + EPS);
        u32x4 w; w.x = cvt_pk_bf16(v[0] * r * g[0], v[1] * r * g[1]); w.y = cvt_pk_bf16(v[2] * r * g[2], v[3] * r * g[3]); w.z = cvt_pk_bf16(v[4] * r * g[4], v[5] * r * g[5]); w.w = cvt_pk_bf16(v[6] * r * g[6], v[7] * r * g[7]);
        *(u32x4*)(MIX + (size_t)m * D + 256 + lane * 8) = w;
    }
}

__device__ __forceinline__ void ln16(f32x4 (&v)[4], const float* g, const float* bb, int lane) {
    float s = 0.f;
#pragma unroll
    for (int j = 0; j < 4; ++j) s += (v[j][0] + v[j][1]) + (v[j][2] + v[j][3]);
    const float mean = wave_sum(s) * (1.f / D); float s2 = 0.f;
#pragma unroll
    for (int j = 0; j < 4; ++j) { v[j] = v[j] - mean; s2 += (v[j][0] * v[j][0] + v[j][1] * v[j][1]) + (v[j][2] * v[j][2] + v[j][3] * v[j][3]); }
    const float rstd = rsqrtf(wave_sum(s2) * (1.f / D) + EPS);
#pragma unroll
    for (int j = 0; j < 4; ++j) { const f32x4 gg = *(const f32x4*)(g + 4 * (lane + 64 * j)), b4 = *(const f32x4*)(bb + 4 * (lane + 64 * j)); v[j] = v[j] * rstd * gg + b4; }
}

__device__ __forceinline__ void phase_ln1_router(CArgs& a, int layer, LAS unsigned char* lds, int G) {
    int tid = threadIdx.x; asm volatile("" : "+v"(tid)); const int lane = tid & 63, wid = tid >> 6;
    const float* T = (const float*)(a.ws + WS_T); float* H1F = a.out; bf16_t* H1B = (bf16_t*)(a.ws + WS_XB);
    const float* g1 = (const float*)a.in[15] + layer * D; const float* b1 = (const float*)a.in[16] + layer * D; const float* rw = (const float*)a.in[17]; const float* rb = (const float*)a.in[18];
    gu32* cw = (gu32*)(a.ws + WS_CTL) + CW_CNT + layer * 16 * 64;
    int* ltok = (int*)(a.ws + WS_LTOK); int* lslot = (int*)(a.ws + WS_LSLOT); float* lwt = (float*)(a.ws + WS_LW);
    LAS float* rwT = (LAS float*)lds;
    LAS int* lcnt = (LAS int*)(lds + 65536);
    LAS int* rec_e = (LAS int*)(lds + 65536 + 256);
    LAS int* rec_p = (LAS int*)(lds + 65536 + 256 + 512);
    LAS float* rec_w = (LAS float*)(lds + 65536 + 256 + 1024);
    for (int c = tid; c < D; c += NWAVES * 64) {
#pragma unroll
        for (int e = 0; e < 16; ++e) rwT[e * 1024 + c] = rw[c * 16 + e]; }
    for (int base = blockIdx.x * 64; base < M; base += G * 64) {
        if (tid < 16) lcnt[tid] = 0;
        __syncthreads();
        for (int rr = 0; rr < 8; ++rr) {
            const int lr = rr * 8 + wid, m = base + lr;
            f32x4 v[4];
#pragma unroll
            for (int j = 0; j < 4; ++j) v[j] = *(const f32x4*)(T + (size_t)m * D + 4 * (lane + 64 * j));
            ln16(v, g1, b1, lane);
#pragma unroll
            for (int j = 0; j < 4; ++j) { *(f32x4*)(H1F + (size_t)m * D + 4 * (lane + 64 * j)) = v[j];
                u32x2 w; w.x = cvt_pk_bf16(v[j][0], v[j][1]); w.y = cvt_pk_bf16(v[j][2], v[j][3]); *(u32x2*)(H1B + (size_t)m * D + 4 * (lane + 64 * j)) = w; }
            float sc[16];
#pragma unroll
            for (int e = 0; e < 16; ++e) { float acc = 0.f;
#pragma unroll
                for (int j = 0; j < 4; ++j) { const f32x4 w4 = *(const LAS f32x4*)(rwT + e * 1024 + 4 * (lane + 64 * j)); acc += v[j][0] * w4[0] + v[j][1] * w4[1] + v[j][2] * w4[2] + v[j][3] * w4[3]; }
                acc = wave_sum(acc); sc[e] = 1.f / (1.f + __expf(-acc)); }
            int bg = 0; float bgs = -1e30f;
#pragma unroll
            for (int gi = 0; gi < 4; ++gi) { float t1 = -1e30f, t2 = -1e30f;
#pragma unroll
                for (int j = 0; j < 4; ++j) { const float x = sc[gi * 4 + j] + rb[gi * 4 + j]; if (x > t1) { t2 = t1; t1 = x; } else if (x > t2) t2 = x; }
                const float gs = t1 + t2; if (gs > bgs) { bgs = gs; bg = gi; } }
            int i1 = 0, i2 = 0; float v1 = -1e30f, v2 = -1e30f, s1 = 0.f, s2 = 0.f;
#pragma unroll
            for (int e = 0; e < 16; ++e) { if ((e >> 2) == bg) { const float x = sc[e] + rb[e];
                if (x > v1) { v2 = v1; i2 = i1; s2 = s1; v1 = x; i1 = e; s1 = sc[e]; } else if (x > v2) { v2 = x; i2 = e; s2 = sc[e]; } } }
            if (lane == 0) { const float ws_ = 1.f / (s1 + s2);
                rec_e[lr * 2] = i1; rec_e[lr * 2 + 1] = i2; rec_w[lr * 2] = s1 * ws_; rec_w[lr * 2 + 1] = s2 * ws_;
                rec_p[lr * 2] = atomicAdd((int*)&lcnt[i1], 1); rec_p[lr * 2 + 1] = atomicAdd((int*)&lcnt[i2], 1); }
        }
        __syncthreads();
        if (tid < 16) lcnt[16 + tid] = (int)__hip_atomic_fetch_add(cw + 64 * tid, (unsigned)lcnt[tid], RLX_AGENT);
        __syncthreads();
        if (tid < 128) { const int lr = tid >> 1, k = tid & 1, e = rec_e[tid], p = lcnt[16 + e] + rec_p[tid], m = base + lr;
            ltok[e * M + p] = m; lslot[e * M + p] = 2 * m + k; lwt[e * M + p] = rec_w[tid]; }
        __syncthreads();
    }
}

__device__ __forceinline__ void phase_ln2(CArgs& a, int layer, int gw, int NGW, int lane) {
    const float* T2 = (const float*)(a.ws + WS_T); const bf16_t* FFN = (const bf16_t*)(a.ws + WS_FFN); bf16_t* XB = (bf16_t*)(a.ws + WS_XB);
    const float* g2 = (const float*)a.in[24] + layer * D; const float* b2 = (const float*)a.in[25] + layer * D;
    for (int m = gw; m < M; m += NGW) {
        f32x4 v[4];
#pragma unroll
        for (int j = 0; j < 4; ++j) { const size_t c = 4 * (lane + 64 * j); v[j] = *(const f32x4*)(T2 + (size_t)m * D + c);
            const u32x2 f0 = *(const u32x2*)(FFN + (size_t)(2 * m) * D + c), f1 = *(const u32x2*)(FFN + (size_t)(2 * m + 1) * D + c);
            v[j][0] += bflo(f0.x) + bflo(f1.x); v[j][1] += bfhi(f0.x) + bfhi(f1.x); v[j][2] += bflo(f0.y) + bflo(f1.y); v[j][3] += bfhi(f0.y) + bfhi(f1.y); }
        ln16(v, g2, b2, lane);
#pragma unroll
        for (int j = 0; j < 4; ++j) { *(f32x4*)(a.out + (size_t)m * D + 4 * (lane + 64 * j)) = v[j];
            u32x2 w; w.x = cvt_pk_bf16(v[j][0], v[j][1]); w.y = cvt_pk_bf16(v[j][2], v[j][3]); *(u32x2*)(XB + (size_t)m * D + 4 * (lane + 64 * j)) = w; }
    }
}

__global__ void __launch_bounds__(NWAVES * 64, 2) fwd(Args a_unused) {
    CArgs* ap = (CArgs*)__builtin_amdgcn_kernarg_segment_ptr();
#define a (*ap)
#define FRESH() asm volatile("" : "+s"(ap))
    extern __shared__ __attribute__((aligned(16))) unsigned char lds_raw[];
    LAS unsigned char* lds = (LAS unsigned char*)lds_raw;
    volatile LAS unsigned* MISC = (volatile LAS unsigned*)(lds + MISC_OFF);
    const int G = gridDim.x; const int bx = blockIdx.x; const int vcu = (G % 8 == 0) ? (bx % 8) * (G / 8) + bx / 8 : bx;
    const int NGW = G * NWAVES;
    for (int u = threadIdx.x; u < (LDS_BYTES - MISC_OFF) / 4; u += NWAVES * 64) ((LAS unsigned*)(lds + MISC_OFF))[u] = 0u;
    __syncthreads();
    XcdBarrier bar; bar.bar = (unsigned*)(a.ws + WS_CTL) + CW_BAR; bar.x = 0; bar.st = nullptr;
    if (a.use_bar) bar = xcd_barrier_post((unsigned*)(a.ws + WS_CTL) + CW_BAR, MISC + 8);
#ifndef PHMASK
#define PHMASK 0x3ff
#endif
#define PHM(k) ((PHMASK >> (k)) & 1)
#define IN(k) (a.ph_lo <= (k) && (k) < a.ph_hi)
#define SEAM(k) do { if (a.use_bar && IN((k) + 1)) xcd_barrier(bar); } while (0)
    for (int layer = 0; layer < 2; ++layer) {
        const int pb = layer * PH_PER_LAYER;
#define PHASE_BEGIN() FRESH(); int tid = threadIdx.x; asm volatile("" : "+v"(tid)); const int lane = tid & 63; const int wave = __builtin_amdgcn_readfirstlane(tid >> 6); const int gw = vcu * NWAVES + wave; (void)lane; (void)gw; unsigned char* ws = a.ws; gu32* ctl = (gu32*)(ws + WS_CTL); bf16_t* U = (bf16_t*)(ws + WS_U); bf16_t* XB = (bf16_t*)(ws + WS_XB); (void)ctl; (void)U; (void)XB
        if (PHM(0) && IN(pb + 0)) { PHASE_BEGIN(); phase_prologue(a, layer, lds, gw, NGW, lane); SEAM(pb + 0); }
        if (PHM(1) && IN(pb + 1)) { PHASE_BEGIN();
            pg8::Gemm g{D, D, D, 0}; SchedStatic S; S.init(XB, D, ws + W_IN, D, M, UP, G, bx); EpiU E{U};
            pg8::gemm_phase<EpiU, SchedStatic, true>(lds, g, S, E);
            SEAM(pb + 1);
        }
        if (PHM(2) && IN(pb + 2)) { PHASE_BEGIN();
            SchedMla S{(const char*)U, (const char*)(ws + W_UQ), (const char*)(ws + W_UKV), G, bx};
            LAS float* rtab = (LAS float*)(lds + LDSX_OFF);
            const f32x2* CS = (const f32x2*)(ws + WS_CS); bf16_t* MK = (bf16_t*)(ws + WS_MK);
            Unit u0;
            if (S.next(0, u0)) {
                const int c0 = u0.e ? U_CKV : U_CQ, nl = u0.e ? 32 : 48; const float invn = u0.e ? (1.f / 128.f) : (1.f / 192.f);
                for (int r = 0; r < 32; ++r) { const int rt = wave * 32 + r; float s = 0.f;
                    if (lane < nl) { const u32x2 w = *(const u32x2*)(U + (size_t)(u0.pm * 256 + rt) * UP + c0 + lane * 4); const float x0 = bflo(w.x), x1 = bfhi(w.x), x2 = bflo(w.y), x3 = bfhi(w.y); s = x0 * x0 + x1 * x1 + x2 * x2 + x3 * x3; }
                    s = wave_sum(s); if (lane == 0) rtab[rt] = rsqrtf(s * invn + EPS); }
                if (u0.e == 1 && u0.pn == 0) {
                    for (int i = tid; i < 256 * 16; i += NWAVES * 64) { const int rt = i >> 4, k = i & 15; const size_t row = (size_t)u0.pm * 256 + rt;
                        const float x1 = bf2f(U[row * UP + U_KR + k]), x2 = bf2f(U[row * UP + U_KR + 16 + k]); const f32x2 cs = CS[row * 16 + k];
                        const unsigned w = cvt_pk_bf16(x1 * cs.x - x2 * cs.y, x1 * cs.y + x2 * cs.x);
#pragma unroll
                        for (int hh = 0; hh < 4; ++hh) { MK[row * 384 + hh * 96 + 64 + k] = (bf16_t)(w & 0xffffu); MK[row * 384 + hh * 96 + 80 + k] = (bf16_t)(w >> 16); } }
                }
                __syncthreads();
            }
            pg8::Gemm g{256, UP, 256, 0}; EpiMla E{(bf16_t*)(ws + WS_MQ), MK, (bf16_t*)(ws + WS_MV), CS, rtab};
            pg8::gemm_phase<EpiMla, SchedMla, false>(lds, g, S, E);
            SEAM(pb + 2);
        }
        if (PHM(3) && IN(pb + 3)) { PHASE_BEGIN();
            gu32* qh = ctl + CW_Q + 64 * layer; LAS int* uid = (LAS int*)(lds + AT_UID);
            const int* pos = (const int*)a.in[2]; const int* pmm = (const int*)(ws + WS_PMM); const float* relb = (const float*)a.in[13];
            bf16_t* MIX = (bf16_t*)(ws + WS_MIX);
            for (;;) {
                if (tid == 0) *uid = (int)__hip_atomic_fetch_add(qh, 1u, RLX_AGENT);
                __syncthreads();
                const int u = __builtin_amdgcn_readfirstlane(*uid);
                __syncthreads();
                if (u >= 128 + 768) break;
                if (u < 128) {
#ifndef NO_SB
                    sb_task(U, MIX, u * 8 + wave, lane);
#endif
                }
                else { const int v = u - 128, qb = 31 - v / 24, w = v % 24;
#ifndef NO_DIFF
                    if (w < 16) { const int bh = w >> 1, mp = w & 1, b = bh >> 2, h = bh & 3;
                        attn_unit<4, 4, true>(lds, U + U_DQ + h * 128 + mp * 64, UP, U + U_DK + h * 128 + mp * 64, UP, U + U_DV + h * 128, UP,
                                              (bf16_t*)(ws + (mp ? WS_D2 : WS_D1)) + h * 128, 512, b, qb, pos, pmm, relb + h);
                    }
#endif
#ifndef NO_MLA
                    if (w >= 16) { const int bh = w - 16, b = bh >> 2, h = bh & 3;
                        attn_unit<6, 2, false>(lds, (const bf16_t*)(ws + WS_MQ) + h * 96, 384, (const bf16_t*)(ws + WS_MK) + h * 96, 384, (const bf16_t*)(ws + WS_MV) + h * 64, 256,
                                               MIX + h * 64, D, b, qb, pos, pmm, relb); }
#endif
                }
            }
            SEAM(pb + 3);
        }
        if (PHM(4) && IN(pb + 4)) { PHASE_BEGIN(); phase_combine(a, layer, gw, NGW, lane); SEAM(pb + 4); }
        if (PHM(5) && IN(pb + 5)) { PHASE_BEGIN();
            pg8::Gemm g{D, D, D, 0}; SchedStatic S; S.init(ws + WS_MIX, D, ws + W_O, D, M, D, G, bx);
            EpiResid E{layer == 0 ? (const float*)a.in[0] : (const float*)a.out, (float*)(ws + WS_T)};
            pg8::gemm_phase<EpiResid, SchedStatic, false>(lds, g, S, E);
            SEAM(pb + 5);
        }
        if (PHM(6) && IN(pb + 6)) { PHASE_BEGIN(); phase_ln1_router(a, layer, lds, G); SEAM(pb + 6); }
        if (PHM(7) && IN(pb + 7)) { PHASE_BEGIN();
            LAS int* mtab = (LAS int*)(lds + LDSX_OFF + 2048); MoeTiles::build(mtab, ctl + CW_CNT + layer * 16 * 64); __syncthreads(); MoeTiles MT{mtab};
            { pg8::Gemm g{D, D, D, 0}; SchedMoe1 S{MT, (const char*)XB, (const char*)(ws + W_GU), (const int*)(ws + WS_LTOK), G, bx}; EpiMoe1 E{MT, (bf16_t*)(ws + WS_HID)};
              pg8::gemm_phase<EpiMoe1, SchedMoe1, true>(lds, g, S, E); }
            { pg8::Gemm g{256, 256, 256, 0}; SchedStatic S; S.init(ws + WS_PB, 256, ws + W_PP, 256, M, D, G, bx); EpiBf16 E{(bf16_t*)(ws + WS_PPO), D, 0};
              pg8::gemm_phase<EpiBf16, SchedStatic, false>(lds, g, S, E); }
            SEAM(pb + 7);
        }
        if (PHM(8) && IN(pb + 8)) { PHASE_BEGIN();
            LAS int* mtab = (LAS int*)(lds + LDSX_OFF + 2048); MoeTiles::build(mtab, ctl + CW_CNT + layer * 16 * 64); __syncthreads(); MoeTiles MT{mtab};
            { pg8::Gemm g{512, 512, 512, 0}; SchedMoe2 S{MT, (const char*)(ws + WS_HID), (const char*)(ws + W_D), G, bx}; EpiMoe2 E{(bf16_t*)(ws + WS_FFN), (const int*)(ws + WS_LSLOT), (const float*)(ws + WS_LW)};
              pg8::gemm_phase<EpiMoe2, SchedMoe2, true>(lds, g, S, E); }
            { pg8::Gemm g{D, D, D, 0}; SchedStatic S; S.init(XB, D, ws + W_PG, D, M, D, G, bx); EpiPle E{a.out, (const bf16_t*)(ws + WS_PPO), (float*)(ws + WS_T)};
              pg8::gemm_phase<EpiPle, SchedStatic, false>(lds, g, S, E); }
            SEAM(pb + 8);
        }
        if (PHM(9) && IN(pb + 9)) { PHASE_BEGIN(); phase_ln2(a, layer, gw, NGW, lane); if (layer == 0) SEAM(pb + 9); }
    }
#undef IN
#undef SEAM
#undef a
#undef FRESH
}

static int g_grid = 0;
static bool setup() {
    if (g_grid) return g_grid > 0;
    int dev = 0, cus = 0;
    if (hipGetDevice(&dev) != hipSuccess || hipDeviceGetAttribute(&cus, hipDeviceAttributeMultiprocessorCount, dev) != hipSuccess) { g_grid = -1; return false; }
    if (hipFuncSetAttribute((const void*)fwd, hipFuncAttributeMaxDynamicSharedMemorySize, LDS_BYTES) != hipSuccess) { g_grid = -1; return false; }
    int per_cu = 0; (void)hipOccupancyMaxActiveBlocksPerMultiprocessor(&per_cu, (const void*)fwd, NWAVES * 64, LDS_BYTES); (void)hipGetLastError();
    g_grid = cus;
    return true;
}
static void launch_range(void* const* d_in, float* d_out, unsigned char* ws, hipStream_t st, int lo, int hi, int use_bar) {
    Args a{}; for (int i = 0; i < 26; ++i) a.in[i] = d_in[i];
    a.out = d_out; a.ws = ws; a.ph_lo = lo; a.ph_hi = hi; a.use_bar = use_bar; a.pad = 0;
    hipLaunchKernelGGL(fwd, dim3(g_grid), dim3(NWAVES * 64), LDS_BYTES, st, a);
}
}

extern "C" void kernel_launch(void* const* d_in, const int* in_sizes, int n_in, void* d_out, int out_size, void* d_ws, size_t ws_size, hipStream_t stream) {
    if (n_in != 26 || ws_size < fk::WS_END || !fk::setup()) return;
    (void)hipMemsetAsync((char*)d_ws + fk::WS_CTL, 0, fk::CTL_ZERO_BYTES, stream);
    fk::launch_range(d_in, (float*)d_out, (unsigned char*)d_ws, stream, 0, fk::N_PHASES, 1);
}
```
